# Optimizing an MI355X kernel written in HIP

```python
import math
import jax, jax.numpy as jnp
from jax import lax
import numpy as np

D_MODEL = 2048
BATCH = 8
SEQ = 2048
DEPTH = 4

GRID_W = 64

MLA_HEADS = 8
MLA_Q_LORA = D_MODEL // 4
MLA_KV_LORA = D_MODEL // 8
MLA_NOPE = 128
MLA_ROPE = 64
MLA_V = (D_MODEL // 2) // MLA_HEADS
MLA_WIDTH = MLA_HEADS * MLA_V
ROPE_BASE = 10000.0
Q_BLOCK = 128

NAT_HEAD_DIM = 64
NAT_HEADS = (D_MODEL // 2) // NAT_HEAD_DIM
NAT_WIDTH = NAT_HEADS * NAT_HEAD_DIM
NAT_WIN_R = 8
NAT_WIN_C = 16

D_MIX = MLA_WIDTH + NAT_WIDTH

IN_WIDTHS = (MLA_Q_LORA, MLA_KV_LORA, MLA_ROPE, NAT_WIDTH, NAT_WIDTH, NAT_WIDTH)
D_IN = sum(IN_WIDTHS)
IN_OFFSETS = [int(o) for o in np.cumsum(IN_WIDTHS)[:-1]]

PEER_HEADS = 8
PEER_N_KEYS = 128
PEER_N_EXPERTS = PEER_N_KEYS * PEER_N_KEYS
PEER_TOPK = 16
PEER_D_QUERY = 256
PEER_TOKEN_BLOCK = 128

RMS_EPS = 1e-6

kernel_name = "hymba_mla_natten_peer_encoder"


def rms_norm(x, g):
    xf = x.astype(jnp.float32)
    y = xf * lax.rsqrt(jnp.mean(xf * xf, axis=-1, keepdims=True) + RMS_EPS)
    return (y * g.astype(jnp.float32)).astype(x.dtype)


def rope_tables(seq_len):
    inv = ROPE_BASE ** (-jnp.arange(0, MLA_ROPE, 2, dtype=jnp.float32) / MLA_ROPE)
    ang = jnp.arange(seq_len, dtype=jnp.float32)[:, None] * inv[None, :]
    return jnp.cos(ang), jnp.sin(ang)


def apply_rope(t, cos, sin):
    tf = t.astype(jnp.float32)
    half = tf.shape[-1] // 2
    t1, t2 = tf[..., :half], tf[..., half:]
    return jnp.concatenate([t1 * cos - t2 * sin, t2 * cos + t1 * sin], axis=-1).astype(t.dtype)


def mla_group(c_q, c_kv, k_pe, q_norm, w_uq, kv_norm, w_ukv):
    B, S, _ = c_q.shape
    cos, sin = rope_tables(S)
    q = (rms_norm(c_q, q_norm) @ w_uq).reshape(B, S, MLA_HEADS, MLA_NOPE + MLA_ROPE)
    q_nope = q[..., :MLA_NOPE]
    q_pe = apply_rope(q[..., MLA_NOPE:], cos[:, None, :], sin[:, None, :])
    k_pe = apply_rope(k_pe, cos, sin)
    kv = (rms_norm(c_kv, kv_norm) @ w_ukv).reshape(B, S, MLA_HEADS, MLA_NOPE + MLA_V)
    k_nope, v = kv[..., :MLA_NOPE], kv[..., MLA_NOPE:]
    scale = (MLA_NOPE + MLA_ROPE) ** -0.5
    n_blk = S // Q_BLOCK

    def to_blocks(t):
        return jnp.moveaxis(t.reshape(B, n_blk, Q_BLOCK, *t.shape[2:]), 1, 0)

    def attend(blk):
        qn, qp = blk
        s = (jnp.einsum('bqhd,bkhd->bhqk', qn, k_nope, preferred_element_type=jnp.float32)
             + jnp.einsum('bqhd,bkd->bhqk', qp, k_pe, preferred_element_type=jnp.float32))
        p = jax.nn.softmax(s * scale, axis=-1).astype(v.dtype)
        return jnp.einsum('bhqk,bkhd->bqhd', p, v)

    o = lax.map(attend, (to_blocks(q_nope), to_blocks(q_pe)))
    return jnp.moveaxis(o, 0, 1).reshape(B, S, MLA_WIDTH)


def nat_group(q, k, v, rpb):
    B, S, _ = q.shape
    rows = S // GRID_W
    kr = min(NAT_WIN_R, rows)
    n_cb = GRID_W // NAT_WIN_C
    band_w = 2 * NAT_WIN_C

    def grid(t):
        return t.reshape(B, rows, GRID_W, NAT_HEADS, NAT_HEAD_DIM)

    q = grid(q * (NAT_HEAD_DIM ** -0.5))
    k = grid(k)
    v = grid(v)
    cb = np.clip(np.arange(n_cb) * NAT_WIN_C - NAT_WIN_C // 2, 0, GRID_W - band_w)
    key_cols = cb[:, None] + np.arange(band_w)
    q_cols = np.arange(n_cb)[:, None] * NAT_WIN_C + np.arange(NAT_WIN_C)
    c_start = np.clip(q_cols - NAT_WIN_C // 2, 0, GRID_W - NAT_WIN_C)
    kc = key_cols[:, None, :]
    col_mask = (kc >= c_start[..., None]) & (kc < c_start[..., None] + NAT_WIN_C)
    dc_idx = np.clip(kc - q_cols[..., None], -(NAT_WIN_C - 1), NAT_WIN_C - 1) + (NAT_WIN_C - 1)
    mask = jnp.asarray(col_mask)[:, :, None, :]

    def attend_row(r):
        rs = jnp.clip(r - kr // 2, 0, rows - kr)
        q_row = lax.dynamic_index_in_dim(q, r, axis=1, keepdims=False)
        q_row = q_row.reshape(B, n_cb, NAT_WIN_C, NAT_HEADS, NAT_HEAD_DIM)
        k_band = lax.dynamic_slice_in_dim(k, rs, kr, axis=1)[:, :, key_cols]
        v_band = lax.dynamic_slice_in_dim(v, rs, kr, axis=1)[:, :, key_cols]
        dr_idx = rs + jnp.arange(kr) - r + (NAT_WIN_R - 1)
        bias = rpb[:, dr_idx][:, :, dc_idx]
        bias = jnp.transpose(bias, (0, 2, 3, 1, 4)).astype(jnp.float32)
        s = jnp.einsum('bnqhd,binkhd->bhnqik', q_row, k_band,
                       preferred_element_type=jnp.float32) + bias
        s = jnp.where(mask, s, -jnp.inf)
        p = jax.nn.softmax(s.reshape(*s.shape[:4], kr * band_w), axis=-1)
        p = p.reshape(s.shape).astype(v.dtype)
        o = jnp.einsum('bhnqik,binkhd->bnqhd', p, v_band)
        return o.reshape(B, GRID_W, NAT_WIDTH)

    o = lax.map(attend_row, jnp.arange(rows))
    return jnp.moveaxis(o, 0, 1).reshape(B, S, NAT_WIDTH)


def peer_ffn(h, w_q, sub_keys, u, v):
    B, S, D = h.shape
    half = PEER_D_QUERY // 2
    q = (h @ w_q).reshape(B, S, PEER_HEADS, PEER_D_QUERY)
    s1 = jnp.einsum('bshd,nd->bshn', q[..., :half], sub_keys[0], preferred_element_type=jnp.float32)
    s2 = jnp.einsum('bshd,nd->bshn', q[..., half:], sub_keys[1], preferred_element_type=jnp.float32)
    v1, i1 = lax.top_k(s1, PEER_TOPK)
    v2, i2 = lax.top_k(s2, PEER_TOPK)
    cand_s = (v1[..., :, None] + v2[..., None, :]).reshape(B, S, PEER_HEADS, PEER_TOPK * PEER_TOPK)
    cand_i = (i1[..., :, None] * PEER_N_KEYS + i2[..., None, :]).reshape(B, S, PEER_HEADS, PEER_TOPK * PEER_TOPK)
    top_s, pos = lax.top_k(cand_s, PEER_TOPK)
    idx = jnp.take_along_axis(cand_i, pos, axis=-1)
    g = jax.nn.softmax(top_s, axis=-1)
    T = B * S
    K = PEER_HEADS * PEER_TOPK
    n_blk = T // PEER_TOKEN_BLOCK
    hb = h.reshape(n_blk, PEER_TOKEN_BLOCK, D)
    ib = idx.reshape(n_blk, PEER_TOKEN_BLOCK, K)
    gb = g.reshape(n_blk, PEER_TOKEN_BLOCK, K)

    def experts(blk):
        h_t, i_t, g_t = blk
        act = jnp.einsum('td,tkd->tk', h_t, u[i_t], preferred_element_type=jnp.float32)
        a = (jax.nn.gelu(act, approximate=False) * g_t).astype(h_t.dtype)
        return jnp.einsum('tk,tkd->td', a, v[i_t])

    y = lax.map(experts, (hb, ib, gb))
    return y.reshape(B, S, D)


def setup_inputs(seed: int = 0) -> dict:
    key = jax.random.key(seed)
    ks = jax.random.split(key, 17)
    L, D = DEPTH, D_MODEL
    f32 = jnp.float32

    def nrm(k, shape, scale):
        return jax.random.normal(k, shape, f32) * scale

    def gain(k, shape):
        return 1.0 + 0.02 * jax.random.normal(k, shape, f32)

    return {
        "x": jax.random.normal(ks[0], (BATCH, SEQ, D), f32),
        "attn_norm": gain(ks[1], (L, D)),
        "w_in": nrm(ks[2], (L, D, D_IN), D ** -0.5),
        "mla_q_norm": gain(ks[3], (L, MLA_Q_LORA)),
        "mla_w_uq": nrm(ks[4], (L, MLA_Q_LORA, MLA_HEADS * (MLA_NOPE + MLA_ROPE)), MLA_Q_LORA ** -0.5),
        "mla_kv_norm": gain(ks[5], (L, MLA_KV_LORA)),
        "mla_w_ukv": nrm(ks[6], (L, MLA_KV_LORA, MLA_HEADS * (MLA_NOPE + MLA_V)), MLA_KV_LORA ** -0.5),
        "nat_rpb": nrm(ks[7], (L, NAT_HEADS, 2 * NAT_WIN_R - 1, 2 * NAT_WIN_C - 1), 0.1),
        "mla_out_norm": gain(ks[8], (L, MLA_WIDTH)),
        "nat_out_norm": gain(ks[9], (L, NAT_WIDTH)),
        "w_out": nrm(ks[10], (L, D_MIX, D), D_MIX ** -0.5),
        "ffn_norm": gain(ks[11], (L, D)),
        "peer_w_q": nrm(ks[12], (L, D, PEER_HEADS * PEER_D_QUERY), D ** -0.5),
        "peer_sub_keys": nrm(ks[13], (L, 2, PEER_N_KEYS, PEER_D_QUERY // 2), (PEER_D_QUERY // 2) ** -0.5),
        "peer_u": nrm(ks[14], (L, PEER_N_EXPERTS, D), D ** -0.5),
        "peer_v": nrm(ks[15], (L, PEER_N_EXPERTS, D), PEER_HEADS ** -0.5),
        "final_norm": gain(ks[16], (D,)),
    }


def reference(x, attn_norm, w_in, mla_q_norm, mla_w_uq, mla_kv_norm, mla_w_ukv, nat_rpb,
              mla_out_norm, nat_out_norm, w_out, ffn_norm, peer_w_q, peer_sub_keys,
              peer_u, peer_v, final_norm):
    for l in range(DEPTH):
        h = rms_norm(x, attn_norm[l])
        proj = h @ w_in[l]
        c_q, c_kv, k_pe, nq, nk, nv = jnp.split(proj, IN_OFFSETS, axis=-1)
        mla_o = mla_group(c_q, c_kv, k_pe, mla_q_norm[l], mla_w_uq[l], mla_kv_norm[l], mla_w_ukv[l])
        nat_o = nat_group(nq, nk, nv, nat_rpb[l])
        mixed = jnp.concatenate([rms_norm(mla_o, mla_out_norm[l]),
                                 rms_norm(nat_o, nat_out_norm[l])], axis=-1)
        x = x + mixed @ w_out[l]
        x = x + peer_ffn(rms_norm(x, ffn_norm[l]), peer_w_q[l], peer_sub_keys[l], peer_u[l], peer_v[l])
    return rms_norm(x, final_norm)
```

```cpp
#include <cstdio>
#include <hip/hip_runtime.h>
namespace pg8 {
#define PG8_LAS __attribute__((address_space(3)))
typedef unsigned short bf16_t;
typedef short bf16x8 __attribute__((ext_vector_type(8)));
typedef float f32x4 __attribute__((ext_vector_type(4)));
typedef unsigned u32x4 __attribute__((ext_vector_type(4)));
constexpr int BM = 256, BK = 64, HALF = 128, HTB = HALF * BK * 2  , STAGE_BYTES = 8 * HTB, NXCD = 8, WGM = 8;

__host__ __device__ __forceinline__ int lds_byte(int r, int c) { const int st = (r >> 4) * 2 + (c >> 5), rr = r & 15, cc = c & 31, ob = rr * 64 + cc * 2; return st * 1024 + (ob ^ (((ob >> 9) & 1) << 5)); }
__host__ __device__ __forceinline__ void stage_rc(int b, int& R, int& C) { const int st = b / 1024, sb = b % 1024, swz = sb ^ (((sb >> 9) & 1) << 5); R = (st >> 1) * 16 + swz / 64; C = (st & 1) * 32 + (swz % 64) / 2; }
__host__ __device__ __forceinline__ int perm32(int rho) { const int n = rho >> 4, i = rho & 15; return 8 * (i >> 2) + 4 * n + (i & 3); }

struct Unit { int pm, pn; };
struct Gemm { const bf16_t* A; const bf16_t* Bt; int M, N, K, pad; };

struct StaticOrder {
    int nM, nN, nwg, G, c;
    __host__ __device__ void init(int M, int N, int G_, int c_) { nM = M / BM; nN = N / BM; nwg = nM * nN; G = G_; c = c_; }
    __host__ __device__ bool next(int i, Unit& u) const {
        const long L = (long)i * G + c; if (L >= nwg) return false;
        int wgid = (int)L; { const int q = nwg / NXCD, r = nwg % NXCD, xcd = wgid % NXCD, off = wgid / NXCD; wgid = (xcd < r ? xcd * (q + 1) : r * (q + 1) + (xcd - r) * q) + off; }
        const int nig = WGM * nN, gid = wgid / nig, fm = gid * WGM, gsz = (nM - fm) < WGM ? (nM - fm) : WGM;
        u.pm = fm + ((wgid % nig) % gsz); u.pn = (wgid % nig) / gsz; return true;
    }
    __device__ __forceinline__ void a_ready(const Unit&) const {}
    __device__ __forceinline__ void done(const Unit&) const {}
};
struct CountedOrder : StaticOrder {
    const unsigned* ready; unsigned need; unsigned* tmo;
    __device__ __forceinline__ void a_ready(const Unit& u) const {
        if (threadIdx.x < 64) {
            const unsigned long long t0 = __builtin_amdgcn_s_memrealtime(); unsigned polls = 0;
            while ((unsigned)__builtin_amdgcn_readfirstlane(__hip_atomic_load(ready + 64 * u.pm, __ATOMIC_RELAXED, __HIP_MEMORY_SCOPE_AGENT)) < need) {
                if ((++polls & 255u) == 0u && __builtin_amdgcn_readfirstlane(__hip_atomic_load(tmo, __ATOMIC_RELAXED, __HIP_MEMORY_SCOPE_AGENT)) != 0u) break;
                if (__builtin_amdgcn_s_memrealtime() - t0 > 2000000ull) {
                    if (threadIdx.x == 0) { unsigned expect = 0u; __hip_atomic_compare_exchange_strong(tmo + 1, &expect, 0x600u | (unsigned)(u.pm & 0xff), __ATOMIC_RELAXED, __ATOMIC_RELAXED, __HIP_MEMORY_SCOPE_AGENT); __hip_atomic_store(tmo, 1u, __ATOMIC_RELAXED, __HIP_MEMORY_SCOPE_AGENT); }
                    break; }
                __builtin_amdgcn_s_sleep(2); }
            __builtin_amdgcn_fence(__ATOMIC_ACQUIRE, "agent");
            asm volatile("s_waitcnt vmcnt(0)" ::: "memory");
        }
#if !defined(BROKEN_HOOK_NO_BARRIER)
        asm volatile("" ::: "memory"); __builtin_amdgcn_s_barrier(); asm volatile("" ::: "memory");
#endif
    }
};

__device__ __forceinline__ unsigned cvt_pk_bf16(float lo, float hi) { unsigned r; asm volatile("v_cvt_pk_bf16_f32 %0, %1, %2" : "=v"(r) : "v"(lo), "v"(hi)); return r; }
typedef float f32x2 __attribute__((ext_vector_type(2)));
__device__ __forceinline__ f32x2 gelu_pk(f32x2 v) {
    const f32x2 av = __builtin_elementwise_abs(v), d = av * 0.2316418882f + 1.0f;
    f32x2 t; t.x = __builtin_amdgcn_rcpf(d.x); t.y = __builtin_amdgcn_rcpf(d.y);
    f32x2 q = t * 0.5307027145f + (-0.7265760135f); q = q * t + 0.7107068705f; q = q * t + (-0.142248368f); q = q * t + 0.127414796f; q = q * t;
    const f32x2 s = (v * v) * (-0.72134752044f);
    f32x2 e; e.x = __builtin_amdgcn_exp2f(s.x); e.y = __builtin_amdgcn_exp2f(s.y);
    const f32x2 m = v * (q * e), r = v - m;
    f32x2 o; o.x = v.x < 0.f ? m.x : r.x; o.y = v.y < 0.f ? m.y : r.y; return o;
}

struct EpiF32 {
    static constexpr bool PERM = false, AFTER_DRAIN = false;
    float* C; int ldc; const float* bias;
    __device__ __forceinline__ void operator()(const f32x4 (&acc)[2][2][4][2], const Unit& u, int wr, int wc, int fr, int fq) const {
        const int row0 = u.pm * BM + wr * 64 + fr, col0 = u.pn * BM + wc * 32 + 4 * fq;
        f32x4 bv[2][2];
#pragma unroll
        for (int bj = 0; bj < 2; ++bj)
#pragma unroll
            for (int n = 0; n < 2; ++n) bv[bj][n] = bias ? *(const f32x4*)(bias + col0 + bj * HALF + n * 16) : (f32x4){0.f, 0.f, 0.f, 0.f};
#pragma unroll
        for (int ai = 0; ai < 2; ++ai)
#pragma unroll
            for (int m = 0; m < 4; ++m) { float* rowp = C + (size_t)(row0 + ai * HALF + m * 16) * ldc + col0;
#pragma unroll
                for (int bj = 0; bj < 2; ++bj)
#pragma unroll
                    for (int n = 0; n < 2; ++n) *(f32x4*)(rowp + bj * HALF + n * 16) = acc[ai][bj][m][n] + bv[bj][n]; }
    }
};
template <int ACT  > struct EpiBf16 {
    static constexpr bool PERM = true, AFTER_DRAIN = false;
    bf16_t* O; const float* bias; size_t split_stride; int ldc; int split_cols;
    __device__ __forceinline__ void operator()(const f32x4 (&acc)[2][2][4][2], const Unit& u, int wr, int wc, int fr, int fq) const {
        const int row0 = u.pm * BM + wr * 64 + fr; int colt = u.pn * BM; bf16_t* base = O;
        if (split_cols) { const int t = colt / split_cols; base += (size_t)t * split_stride; colt -= t * split_cols; }
        const int col0 = colt + wc * 32 + 8 * fq, bcol0 = u.pn * BM + wc * 32 + 8 * fq;
        f32x4 bv[2][2];
#pragma unroll
        for (int bj = 0; bj < 2; ++bj)
#pragma unroll
            for (int n = 0; n < 2; ++n) bv[bj][n] = bias ? *(const f32x4*)(bias + bcol0 + bj * HALF + 4 * n) : (f32x4){0.f, 0.f, 0.f, 0.f};
#pragma unroll
        for (int ai = 0; ai < 2; ++ai)
#pragma unroll
            for (int m = 0; m < 4; ++m) { bf16_t* rowp = base + (size_t)(row0 + ai * HALF + m * 16) * ldc + col0;
#pragma unroll
                for (int bj = 0; bj < 2; ++bj) { f32x4 v0 = acc[ai][bj][m][0] + bv[bj][0], v1 = acc[ai][bj][m][1] + bv[bj][1];
                    if (ACT == 1) { f32x2 a = gelu_pk((f32x2){v0[0], v0[1]}), b = gelu_pk((f32x2){v0[2], v0[3]}), c = gelu_pk((f32x2){v1[0], v1[1]}), d = gelu_pk((f32x2){v1[2], v1[3]});
                        v0 = (f32x4){a.x, a.y, b.x, b.y}; v1 = (f32x4){c.x, c.y, d.x, d.y}; }
                    if (ACT == 2) {
#pragma unroll
                        for (int j = 0; j < 4; ++j) { v0[j] = 0.5f * v0[j] * (1.0f + erff(v0[j] * 0.70710678f)); v1[j] = 0.5f * v1[j] * (1.0f + erff(v1[j] * 0.70710678f)); } }
                    u32x4 w; w.x = cvt_pk_bf16(v0[0], v0[1]); w.y = cvt_pk_bf16(v0[2], v0[3]); w.z = cvt_pk_bf16(v1[0], v1[1]); w.w = cvt_pk_bf16(v1[2], v1[3]);
                    *(u32x4*)(rowp + bj * HALF) = w; } }
    }
};
template <class Epi, class Sched, bool STAMP = false>
__device__ __forceinline__ void gemm_phase(PG8_LAS unsigned char* lds, const Gemm g, const Sched& S, const Epi& E, unsigned long long* stamps) {
    const int tid = threadIdx.x, wid = __builtin_amdgcn_readfirstlane(tid >> 6), lane = tid & 63, wr = wid >> 2, wc = wid & 3, fr = lane & 15, fq = lane >> 4;
    const int K = g.K, nt = K / BK;
    int ts_lo = 0, ts_hi = 0, nts = 0; const unsigned long long rt_entry = STAMP ? (unsigned long long)wall_clock64() : 0ull;
#define PG8_STAMP() do { if (STAMP && wid == 0 && nts < 64) { const unsigned long long _c = (unsigned long long)clock64(); \
        ts_lo = (lane == nts) ? (int)(unsigned)_c : ts_lo; ts_hi = (lane == nts) ? (int)(unsigned)(_c >> 32) : ts_hi; ++nts; } } while (0)
    PG8_STAMP();
    unsigned voffA[2], voffB[2];
#pragma unroll
    for (int i = 0; i < 2; ++i) { int R, C; stage_rc(tid * 16 + i * 8192, R, C); const int Rb = Epi::PERM ? ((R & ~31) + perm32(R & 31)) : R;
        voffA[i] = (unsigned)(R * K + C) * 2u; voffB[i] = (unsigned)(Rb * K + C) * 2u; }
    const size_t kstep = (size_t)(BK * 2);
    const size_t hstep = (size_t)HALF * K * 2;
    const size_t tstep = 2 * hstep;
    const unsigned ldsw = (unsigned)wid * 1024u;
    const int aoff = lds_byte(wr * 64 + fr, fq * 8), boff = lds_byte(wc * 32 + fr, fq * 8);
#define PG8_SA(b, h) (((b) * 2 + (h)) * HTB)
#define PG8_SB(b, h) ((4 + (b) * 2 + (h)) * HTB)
#define PG8_STAGE(bufoff, gbase, voff) do { _Pragma("unroll") for (int _i = 0; _i < 2; ++_i) \
        __builtin_amdgcn_global_load_lds((const unsigned*)((const char*)(gbase) + (voff)[_i]), (PG8_LAS unsigned*)(lds + (bufoff) + ldsw + _i * 8192), 16, 0, 0); } while (0)
#define PG8_LDA(dst, b, h) do { _Pragma("unroll") for (int m = 0; m < 4; ++m) _Pragma("unroll") for (int k = 0; k < 2; ++k) dst[m][k] = *(const PG8_LAS bf16x8*)(lds + PG8_SA(b, h) + aoff + m * 2048 + k * 1024); } while (0)
#define PG8_LDB(dst, b, h) do { _Pragma("unroll") for (int n = 0; n < 2; ++n) _Pragma("unroll") for (int k = 0; k < 2; ++k) dst[n][k] = *(const PG8_LAS bf16x8*)(lds + PG8_SB(b, h) + boff + n * 2048 + k * 1024); } while (0)
#define PG8_MMA(ai, bj, At, Bt) do { __builtin_amdgcn_s_setprio(1); _Pragma("unroll") for (int m = 0; m < 4; ++m) _Pragma("unroll") for (int n = 0; n < 2; ++n) _Pragma("unroll") for (int k = 0; k < 2; ++k) \
        acc[ai][bj][m][n] = __builtin_amdgcn_mfma_f32_16x16x32_bf16(Bt[n][k], At[m][k], acc[ai][bj][m][n], 0, 0, 0); __builtin_amdgcn_s_setprio(0); } while (0)
#define PG8_WAIT_V(n) asm volatile("s_waitcnt vmcnt(" #n ")" ::: "memory")
#define PG8_WAIT_L(n) asm volatile("s_waitcnt lgkmcnt(" #n ")" ::: "memory")
#define PG8_BAR __builtin_amdgcn_s_barrier()
#define PG8_SCHED __builtin_amdgcn_sched_barrier(0)
    Unit cur, nxt; int ui = 0;
    if (!S.next(0, cur)) return;
    f32x4 acc[2][2][4][2];
#pragma unroll
    for (int a = 0; a < 2; ++a)
#pragma unroll
        for (int b = 0; b < 2; ++b)
#pragma unroll
            for (int m = 0; m < 4; ++m)
#pragma unroll
                for (int n = 0; n < 2; ++n) acc[a][b][m][n] = (f32x4){0.f, 0.f, 0.f, 0.f};
    bf16x8 At[4][2], B0[2][2], B1[2][2];
    const char* cA = (const char*)g.A + (size_t)cur.pm * tstep; const char* cB = (const char*)g.Bt + (size_t)cur.pn * tstep;
    S.a_ready(cur);
    PG8_STAGE(PG8_SB(0, 0), cB, voffB); PG8_STAGE(PG8_SA(0, 0), cA, voffA); PG8_STAGE(PG8_SB(0, 1), cB + hstep, voffB); PG8_STAGE(PG8_SA(0, 1), cA + hstep, voffA);
    if (wr == 1) PG8_BAR;
    PG8_WAIT_V(4); PG8_BAR;
    PG8_STAGE(PG8_SB(1, 0), cB + kstep, voffB); PG8_STAGE(PG8_SA(1, 0), cA + kstep, voffA); PG8_STAGE(PG8_SB(1, 1), cB + hstep + kstep, voffB);
    PG8_WAIT_V(6); PG8_BAR;
    PG8_STAMP();
    for (;;) {
        const bool has_next = S.next(ui + 1, nxt);
        const char* nA = has_next ? (const char*)g.A + (size_t)nxt.pm * tstep : cA; const char* nB = has_next ? (const char*)g.Bt + (size_t)nxt.pn * tstep : cB;
        for (int t = 0; t < nt; t += 2) {
            const bool last = (t == nt - 2);
            const char* a1 = cA + (size_t)(t + 1) * kstep;
            const char* a2 = last ? nA : cA + (size_t)(t + 2) * kstep; const char* b2 = last ? nB : cB + (size_t)(t + 2) * kstep;
            const char* a3 = a2 + kstep; const char* b3 = b2 + kstep;
            if (last && has_next) S.a_ready(nxt);
            PG8_LDB(B0, 0, 0); PG8_SCHED; PG8_LDA(At, 0, 0); PG8_STAGE(PG8_SA(1, 1), a1 + hstep, voffA);
            PG8_WAIT_L(8); PG8_BAR; PG8_WAIT_L(0); PG8_MMA(0, 0, At, B0); PG8_BAR; PG8_SCHED;
            PG8_LDB(B1, 0, 1); PG8_STAGE(PG8_SB(0, 0), b2, voffB);
            PG8_BAR; PG8_WAIT_L(0); PG8_MMA(0, 1, At, B1); PG8_BAR;
            PG8_LDA(At, 0, 1); PG8_STAGE(PG8_SA(0, 0), a2, voffA);
            PG8_BAR; PG8_WAIT_L(0); PG8_MMA(1, 0, At, B0); PG8_BAR; PG8_SCHED;
            PG8_STAGE(PG8_SB(0, 1), b2 + hstep, voffB);
            PG8_WAIT_V(6); PG8_BAR; PG8_MMA(1, 1, At, B1); PG8_BAR;
            PG8_LDB(B0, 1, 0); PG8_SCHED; PG8_LDA(At, 1, 0); PG8_STAGE(PG8_SA(0, 1), a2 + hstep, voffA);
            PG8_WAIT_L(8); PG8_BAR; PG8_WAIT_L(0); PG8_MMA(0, 0, At, B0); PG8_BAR; PG8_SCHED;
            PG8_LDB(B1, 1, 1); PG8_STAGE(PG8_SB(1, 0), b3, voffB);
            PG8_BAR; PG8_WAIT_L(0); PG8_MMA(0, 1, At, B1); PG8_BAR;
            PG8_LDA(At, 1, 1); PG8_STAGE(PG8_SA(1, 0), a3, voffA);
            PG8_BAR; PG8_WAIT_L(0); PG8_MMA(1, 0, At, B0); PG8_BAR; PG8_SCHED;
            PG8_STAGE(PG8_SB(1, 1), b3 + hstep, voffB);
            PG8_WAIT_V(6); PG8_BAR; PG8_MMA(1, 1, At, B1); PG8_BAR;
        }
        PG8_STAMP();
        if constexpr (!Epi::AFTER_DRAIN) { E(acc, cur, wr, wc, fr, fq); S.done(cur); }
        PG8_STAMP();
        if (!has_next) break;
#pragma unroll
        for (int a = 0; a < 2; ++a)
#pragma unroll
            for (int b = 0; b < 2; ++b)
#pragma unroll
                for (int m = 0; m < 4; ++m)
#pragma unroll
                    for (int n = 0; n < 2; ++n) acc[a][b][m][n] = (f32x4){0.f, 0.f, 0.f, 0.f};
        cur = nxt; cA = nA; cB = nB; ++ui;
    }
    PG8_WAIT_V(0);
    if (wr == 0) PG8_BAR;
    PG8_BAR;
    if constexpr (Epi::AFTER_DRAIN) { E.fused(acc, cur, wr, wc, fr, fq, lds, wid, lane); S.done(cur); }
    PG8_STAMP();
    if (STAMP && wid == 0) { stamps[lane] = lane < nts ? (((unsigned long long)(unsigned)ts_hi << 32) | (unsigned)ts_lo) : 0ull;
        if (lane == 62) stamps[62] = rt_entry; if (lane == 63) stamps[63] = (unsigned long long)wall_clock64(); }
#undef PG8_STAMP
#undef PG8_SA
#undef PG8_SB
#undef PG8_STAGE
#undef PG8_LDA
#undef PG8_LDB
#undef PG8_MMA
#undef PG8_WAIT_V
#undef PG8_WAIT_L
#undef PG8_BAR
#undef PG8_SCHED
}
}

#define LAS __attribute__((address_space(3)))
typedef unsigned short bf16_t;
typedef float f32x4 __attribute__((ext_vector_type(4)));
typedef unsigned u32x4 __attribute__((ext_vector_type(4)));
typedef unsigned u32x2 __attribute__((ext_vector_type(2)));
typedef __bf16 bf16x2 __attribute__((ext_vector_type(2)));

constexpr int T = 16384, D = 2048, SEQ = 2048, NL = 4;
constexpr int DIN = 3904, DINP = 4096;
constexpr float EPS = 1e-6f;

__device__ __forceinline__ unsigned f2bf(float f) { unsigned u = __float_as_uint(f); return (u + 0x7fffu + ((u >> 16) & 1u)) >> 16; }
__device__ __forceinline__ unsigned pk2(float lo, float hi) { return f2bf(lo) | (f2bf(hi) << 16); }
__device__ __forceinline__ float bflo(unsigned w) { return __uint_as_float(w << 16); }
__device__ __forceinline__ float bfhi(unsigned w) { return __uint_as_float(w & 0xffff0000u); }
__device__ __forceinline__ float wave_sum(float v) {
#pragma unroll
    for (int o = 1; o < 64; o <<= 1) v += __shfl_xor(v, o);
    return v; }
__device__ __forceinline__ float wave_max(float v) {
#pragma unroll
    for (int o = 1; o < 64; o <<= 1) v = fmaxf(v, __shfl_xor(v, o));
    return v; }
__device__ __forceinline__ float dot2(unsigned a, unsigned b, float acc) { return __builtin_amdgcn_fdot2_f32_bf16(__builtin_bit_cast(bf16x2, a), __builtin_bit_cast(bf16x2, b), acc, false); }

__device__ __forceinline__ int src_col(int mode, int n) {
    if (mode == 0) {
        if (n < 768) return n;
        if (n < 3840) return n + 64;
        if (n < 3904) { const int i = n - 3840; return 768 + (i >> 1) + 32 * (i & 1); }
        return -1;
    } else if (mode == 1) {
        const int h = n / 192, i = n % 192; if (i < 128) return n; const int ii = i - 128; return h * 192 + 128 + (ii >> 1) + 32 * (ii & 1);
    } else if (mode == 2) {
        if (n < 1024) { const int h = n >> 7, d = n & 127; return h * 256 + d; }
        const int m = n - 1024, h = m >> 7, d = m & 127; return h * 256 + 128 + d;
    }
    return n;
}
__global__ void __launch_bounds__(256) k_conv_wT(const float* __restrict__ W, bf16_t* __restrict__ WT, int K, int N, int NP, int mode) {
    __shared__ float tile[32][33];
    const int l = blockIdx.z; W += (size_t)l * K * N; WT += (size_t)l * NP * K;
    const int n0 = blockIdx.x * 32, k0 = blockIdx.y * 32, tx = threadIdx.x & 31, ty = threadIdx.x >> 5;
    const int sc = src_col(mode, n0 + tx);
    for (int i = ty; i < 32; i += 8) tile[i][tx] = sc >= 0 ? W[(size_t)(k0 + i) * N + sc] : 0.f;
    __syncthreads();
    for (int i = ty; i < 32; i += 8) WT[(size_t)(n0 + i) * K + k0 + tx] = (bf16_t)f2bf(tile[tx][i]);
}
__global__ void __launch_bounds__(256) k_conv_bf16(const float* __restrict__ in, bf16_t* __restrict__ out, size_t n8) {
    for (size_t i = (size_t)blockIdx.x * blockDim.x + threadIdx.x; i < n8; i += (size_t)gridDim.x * blockDim.x) {
        const f32x4 a = ((const f32x4*)in)[2 * i], b = ((const f32x4*)in)[2 * i + 1];
        u32x4 o; o.x = pk2(a.x, a.y); o.y = pk2(a.z, a.w); o.z = pk2(b.x, b.y); o.w = pk2(b.z, b.w);
        ((u32x4*)out)[i] = o; }
}
__global__ void __launch_bounds__(256) k_conv_keys(const float* __restrict__ in, unsigned* __restrict__ out) {
    const int i = blockIdx.x * 256 + threadIdx.x; if (i >= NL * 2 * 64 * 128) return;
    const int n = i & 127, dp = (i >> 7) & 63, lh = i >> 13;
    const float* s = in + ((size_t)lh * 128 + n) * 128 + 2 * dp; out[i] = pk2(s[0], s[1]);
}
__device__ const double ROPE_REV[32] = {0.15915494309189535, 0.11934937021124886, 0.08949940160889101, 0.06711508300522726, 0.050329212104487035, 0.03774158471741977, 0.0283021958306234, 0.02122365276477766, 0.015915494309189534, 0.011934937021124886, 0.008949940160889102, 0.006711508300522725, 0.005032921210448704, 0.003774158471741977, 0.00283021958306234, 0.0021223652764777662, 0.0015915494309189536, 0.0011934937021124885, 0.0008949940160889102, 0.0006711508300522726, 0.0005032921210448703, 0.00037741584717419774, 0.00028302195830623395, 0.0002122365276477766, 0.00015915494309189535, 0.00011934937021124886, 8.949940160889102e-05, 6.711508300522725e-05, 5.0329212104487035e-05, 3.774158471741978e-05, 2.8302195830623396e-05, 2.122365276477766e-05};
__global__ void __launch_bounds__(256) k_rope_tab(float* __restrict__ tab) {
    const int i = blockIdx.x * 256 + threadIdx.x; if (i >= SEQ * 32) return;
    const int s = i >> 5, j = i & 31;
    double rev = (double)s * ROPE_REV[j]; rev -= __builtin_rint(rev);
    const float r = (float)rev;
    tab[s * 64 + j] = __builtin_amdgcn_cosf(r); tab[s * 64 + 32 + j] = __builtin_amdgcn_sinf(r);
}
__global__ void __launch_bounds__(256) k_norm_x(const float* __restrict__ x, const float* __restrict__ gain, bf16_t* __restrict__ h, float* __restrict__ xcopy) {
    const int lane = threadIdx.x & 63, t = blockIdx.x * 4 + (threadIdx.x >> 6);
    const float* xr = x + (size_t)t * D;
    f32x4 v[8]; float ss = 0.f;
#pragma unroll
    for (int j = 0; j < 4; ++j) { v[2 * j] = *(const f32x4*)(xr + j * 512 + lane * 8); v[2 * j + 1] = *(const f32x4*)(xr + j * 512 + lane * 8 + 4); }
#pragma unroll
    for (int j = 0; j < 8; ++j) ss += v[j].x * v[j].x + v[j].y * v[j].y + v[j].z * v[j].z + v[j].w * v[j].w;
    const float r = 1.0f / sqrtf(wave_sum(ss) * (1.0f / D) + EPS);
#pragma unroll
    for (int j = 0; j < 4; ++j) {
        const f32x4 g0 = *(const f32x4*)(gain + j * 512 + lane * 8), g1 = *(const f32x4*)(gain + j * 512 + lane * 8 + 4);
        const f32x4 a = v[2 * j], b = v[2 * j + 1];
        u32x4 o; o.x = pk2(a.x * r * g0.x, a.y * r * g0.y); o.y = pk2(a.z * r * g0.z, a.w * r * g0.w); o.z = pk2(b.x * r * g1.x, b.y * r * g1.y); o.w = pk2(b.z * r * g1.z, b.w * r * g1.w);
        *(u32x4*)(h + (size_t)t * D + j * 512 + lane * 8) = o;
        if (xcopy) { *(f32x4*)(xcopy + (size_t)t * D + j * 512 + lane * 8) = a; *(f32x4*)(xcopy + (size_t)t * D + j * 512 + lane * 8 + 4) = b; }
    }
}
__global__ void __launch_bounds__(256) k_lat_norm(const bf16_t* __restrict__ cq, const bf16_t* __restrict__ ckv, const float* __restrict__ gq, const float* __restrict__ gkv, bf16_t* __restrict__ cqn, bf16_t* __restrict__ ckvn) {
    const int lane = threadIdx.x & 63, t = blockIdx.x * 4 + (threadIdx.x >> 6);
    { const u32x4 a = *(const u32x4*)(cq + (size_t)t * 512 + lane * 8);
      float f[8] = {bflo(a.x), bfhi(a.x), bflo(a.y), bfhi(a.y), bflo(a.z), bfhi(a.z), bflo(a.w), bfhi(a.w)};
      float ss = 0.f;
#pragma unroll
      for (int i = 0; i < 8; ++i) ss += f[i] * f[i];
      const float r = 1.0f / sqrtf(wave_sum(ss) * (1.0f / 512) + EPS);
      const f32x4 g0 = *(const f32x4*)(gq + lane * 8), g1 = *(const f32x4*)(gq + lane * 8 + 4);
      u32x4 o; o.x = pk2(f[0] * r * g0.x, f[1] * r * g0.y); o.y = pk2(f[2] * r * g0.z, f[3] * r * g0.w); o.z = pk2(f[4] * r * g1.x, f[5] * r * g1.y); o.w = pk2(f[6] * r * g1.z, f[7] * r * g1.w);
      *(u32x4*)(cqn + (size_t)t * 512 + lane * 8) = o; }
    { const u32x2 a = *(const u32x2*)(ckv + (size_t)t * 256 + lane * 4);
      float f[4] = {bflo(a.x), bfhi(a.x), bflo(a.y), bfhi(a.y)};
      const float ss = f[0] * f[0] + f[1] * f[1] + f[2] * f[2] + f[3] * f[3];
      const float r = 1.0f / sqrtf(wave_sum(ss) * (1.0f / 256) + EPS);
      const f32x4 g = *(const f32x4*)(gkv + lane * 4);
      u32x2 o; o.x = pk2(f[0] * r * g.x, f[1] * r * g.y); o.y = pk2(f[2] * r * g.z, f[3] * r * g.w);
      *(u32x2*)(ckvn + (size_t)t * 256 + lane * 4) = o; }
}
__global__ void __launch_bounds__(256) k_mla_norm(bf16_t* __restrict__ mix, const float* __restrict__ g) {
    const int lane = threadIdx.x & 63, t = blockIdx.x * 4 + (threadIdx.x >> 6);
    bf16_t* p = mix + (size_t)t * 2048 + lane * 16;
    const u32x4 a = *(const u32x4*)p, b = *(const u32x4*)(p + 8);
    float f[16] = {bflo(a.x), bfhi(a.x), bflo(a.y), bfhi(a.y), bflo(a.z), bfhi(a.z), bflo(a.w), bfhi(a.w), bflo(b.x), bfhi(b.x), bflo(b.y), bfhi(b.y), bflo(b.z), bfhi(b.z), bflo(b.w), bfhi(b.w)};
    float ss = 0.f;
#pragma unroll
    for (int i = 0; i < 16; ++i) ss += f[i] * f[i];
    const float r = 1.0f / sqrtf(wave_sum(ss) * (1.0f / 1024) + EPS);
    float gg[16];
#pragma unroll
    for (int i = 0; i < 4; ++i) { const f32x4 q = *(const f32x4*)(g + lane * 16 + 4 * i); gg[4 * i] = q.x; gg[4 * i + 1] = q.y; gg[4 * i + 2] = q.z; gg[4 * i + 3] = q.w; }
    u32x4 o0, o1;
    o0.x = pk2(f[0] * r * gg[0], f[1] * r * gg[1]); o0.y = pk2(f[2] * r * gg[2], f[3] * r * gg[3]); o0.z = pk2(f[4] * r * gg[4], f[5] * r * gg[5]); o0.w = pk2(f[6] * r * gg[6], f[7] * r * gg[7]);
    o1.x = pk2(f[8] * r * gg[8], f[9] * r * gg[9]); o1.y = pk2(f[10] * r * gg[10], f[11] * r * gg[11]); o1.z = pk2(f[12] * r * gg[12], f[13] * r * gg[13]); o1.w = pk2(f[14] * r * gg[14], f[15] * r * gg[15]);
    *(u32x4*)p = o0; *(u32x4*)(p + 8) = o1;
}

__device__ __forceinline__ void rope8(f32x4& v0, f32x4& v1, const float* __restrict__ tabrow, int j0) {
    const f32x4 c = *(const f32x4*)(tabrow + j0), s = *(const f32x4*)(tabrow + 32 + j0);
    f32x4 a, b;
    a.x = v0.x * c.x - v0.y * s.x; a.y = v0.y * c.x + v0.x * s.x; a.z = v0.z * c.y - v0.w * s.y; a.w = v0.w * c.y + v0.z * s.y;
    b.x = v1.x * c.z - v1.y * s.z; b.y = v1.y * c.z + v1.x * s.z; b.z = v1.z * c.w - v1.w * s.w; b.w = v1.w * c.w + v1.z * s.w;
    v0 = a; v1 = b;
}
struct EpiIn {
    static constexpr bool PERM = true, AFTER_DRAIN = false;
    bf16_t *cq, *ckv, *nq, *nk, *nv, *kpe; const float* rope;
    __device__ __forceinline__ void operator()(const pg8::f32x4 (&acc)[2][2][4][2], const pg8::Unit& u, int wr, int wc, int fr, int fq) const {
        const int pn = u.pn, row0 = u.pm * 256 + wr * 64 + fr, cit = wc * 32 + 8 * fq;
        if (pn == 15) {
            if (wc < 2) {
#pragma unroll
                for (int ai = 0; ai < 2; ++ai)
#pragma unroll
                    for (int m = 0; m < 4; ++m) { const int row = row0 + ai * 128 + m * 16;
                        f32x4 v0 = acc[ai][0][m][0], v1 = acc[ai][0][m][1];
                        rope8(v0, v1, rope + (size_t)(row & (SEQ - 1)) * 64, cit >> 1);
                        u32x4 w; w.x = pk2(v0.x, v0.y); w.y = pk2(v0.z, v0.w); w.z = pk2(v1.x, v1.y); w.w = pk2(v1.z, v1.w);
                        *(u32x4*)(kpe + (size_t)row * 64 + cit) = w; }
            }
            return;
        }
        bf16_t* base; int ld, c0; float sc = 1.f;
        if (pn < 2) { base = cq; ld = 512; c0 = pn * 256; }
        else if (pn == 2) { base = ckv; ld = 256; c0 = 0; }
        else if (pn < 7) { base = nq; ld = 1024; c0 = (pn - 3) * 256; sc = 0.125f; }
        else if (pn < 11) { base = nk; ld = 1024; c0 = (pn - 7) * 256; }
        else { base = nv; ld = 1024; c0 = (pn - 11) * 256; }
#pragma unroll
        for (int ai = 0; ai < 2; ++ai)
#pragma unroll
            for (int m = 0; m < 4; ++m) { bf16_t* rowp = base + (size_t)(row0 + ai * 128 + m * 16) * ld + c0 + cit;
#pragma unroll
                for (int bj = 0; bj < 2; ++bj) { const f32x4 v0 = acc[ai][bj][m][0] * sc, v1 = acc[ai][bj][m][1] * sc;
                    u32x4 w; w.x = pk2(v0.x, v0.y); w.y = pk2(v0.z, v0.w); w.z = pk2(v1.x, v1.y); w.w = pk2(v1.z, v1.w);
                    *(u32x4*)(rowp + bj * 128) = w; } }
    }
};
struct EpiQ {
    static constexpr bool PERM = true, AFTER_DRAIN = false;
    bf16_t* Q; const float* rope; float qscale; int pad;
    __device__ __forceinline__ void operator()(const pg8::f32x4 (&acc)[2][2][4][2], const pg8::Unit& u, int wr, int wc, int fr, int fq) const {
        const int row0 = u.pm * 256 + wr * 64 + fr;
#pragma unroll
        for (int bj = 0; bj < 2; ++bj) {
            const int col = u.pn * 256 + bj * 128 + wc * 32 + 8 * fq, i = col % 192; const bool rp = i >= 128; const int j0 = (i - 128) >> 1;
#pragma unroll
            for (int ai = 0; ai < 2; ++ai)
#pragma unroll
                for (int m = 0; m < 4; ++m) { const int row = row0 + ai * 128 + m * 16;
                    f32x4 v0 = acc[ai][bj][m][0] * qscale, v1 = acc[ai][bj][m][1] * qscale;
                    if (rp) rope8(v0, v1, rope + (size_t)(row & (SEQ - 1)) * 64, j0);
                    u32x4 w; w.x = pk2(v0.x, v0.y); w.y = pk2(v0.z, v0.w); w.z = pk2(v1.x, v1.y); w.w = pk2(v1.z, v1.w);
                    *(u32x4*)(Q + (size_t)row * 1536 + col) = w; } }
    }
};
struct EpiResid {
    static constexpr bool PERM = false, AFTER_DRAIN = false;
    float* X;
    __device__ __forceinline__ void operator()(const pg8::f32x4 (&acc)[2][2][4][2], const pg8::Unit& u, int wr, int wc, int fr, int fq) const {
        const int row0 = u.pm * 256 + wr * 64 + fr, col0 = u.pn * 256 + wc * 32 + 4 * fq;
#pragma unroll
        for (int ai = 0; ai < 2; ++ai)
#pragma unroll
            for (int m = 0; m < 4; ++m) { float* rowp = X + (size_t)(row0 + ai * 128 + m * 16) * D + col0;
#pragma unroll
                for (int bj = 0; bj < 2; ++bj)
#pragma unroll
                    for (int n = 0; n < 2; ++n) { f32x4* p = (f32x4*)(rowp + bj * 128 + n * 16); *p = *p + acc[ai][bj][m][n]; } }
    }
};
template <class Epi>
__global__ void __launch_bounds__(512, 2) k_gemm(pg8::Gemm g, Epi E) {
    extern __shared__ __attribute__((aligned(16))) unsigned char lds[];
    pg8::StaticOrder S; S.init(g.M, g.N, (int)gridDim.x, (int)blockIdx.x);
    pg8::gemm_phase<Epi, pg8::StaticOrder>((PG8_LAS unsigned char*)lds, g, S, E, nullptr);
}

__device__ __forceinline__ void unpack16(const bf16_t* p, float (&f)[16]) {
    const u32x4 a = *(const u32x4*)p, b = *(const u32x4*)(p + 8);
    f[0] = bflo(a.x); f[1] = bfhi(a.x); f[2] = bflo(a.y); f[3] = bfhi(a.y); f[4] = bflo(a.z); f[5] = bfhi(a.z); f[6] = bflo(a.w); f[7] = bfhi(a.w);
    f[8] = bflo(b.x); f[9] = bfhi(b.x); f[10] = bflo(b.y); f[11] = bfhi(b.y); f[12] = bflo(b.z); f[13] = bfhi(b.z); f[14] = bflo(b.w); f[15] = bfhi(b.w);
}
__global__ void __launch_bounds__(256) k_nat(const bf16_t* __restrict__ nq, const bf16_t* __restrict__ nk, const bf16_t* __restrict__ nv, const float* __restrict__ rpb, const float* __restrict__ gain, bf16_t* __restrict__ mix) {
    __shared__ float rp[16 * 15 * 31];
    for (int i = threadIdx.x; i < 16 * 15 * 31; i += 256) rp[i] = rpb[i];
    __syncthreads();
    const int lane = threadIdx.x & 63, t = blockIdx.x * 4 + (threadIdx.x >> 6);
    const int b = t >> 11, s = t & 2047, r = s >> 6, c = s & 63;
    const int rs = min(max(r - 4, 0), 24), cs = min(max(c - 8, 0), 48), hd = lane >> 2;
    float q[16]; unpack16(nq + (size_t)t * 1024 + lane * 16, q);
    float m = -INFINITY, l = 0.f, o[16];
#pragma unroll
    for (int i = 0; i < 16; ++i) o[i] = 0.f;
    for (int kr = 0; kr < 8; ++kr)
        for (int kc = 0; kc < 16; ++kc) {
            const size_t tk = (size_t)b * 2048 + (rs + kr) * 64 + cs + kc;
            float k[16]; unpack16(nk + tk * 1024 + lane * 16, k);
            float p = 0.f;
#pragma unroll
            for (int i = 0; i < 16; ++i) p += q[i] * k[i];
            p += __shfl_xor(p, 1); p += __shfl_xor(p, 2);
            p += rp[hd * 465 + (rs + kr - r + 7) * 31 + (cs + kc - c + 15)];
            const float mn = fmaxf(m, p), alpha = __expf(m - mn), e = __expf(p - mn);
            l = l * alpha + e; m = mn;
            float v[16]; unpack16(nv + tk * 1024 + lane * 16, v);
#pragma unroll
            for (int i = 0; i < 16; ++i) o[i] = o[i] * alpha + e * v[i];
        }
    const float il = 1.0f / l; float ss = 0.f;
#pragma unroll
    for (int i = 0; i < 16; ++i) { o[i] *= il; ss += o[i] * o[i]; }
    const float rr = 1.0f / sqrtf(wave_sum(ss) * (1.0f / 1024) + EPS);
    float gg[16];
#pragma unroll
    for (int i = 0; i < 4; ++i) { const f32x4 qg = *(const f32x4*)(gain + lane * 16 + 4 * i); gg[4 * i] = qg.x; gg[4 * i + 1] = qg.y; gg[4 * i + 2] = qg.z; gg[4 * i + 3] = qg.w; }
    u32x4 o0, o1;
    o0.x = pk2(o[0] * rr * gg[0], o[1] * rr * gg[1]); o0.y = pk2(o[2] * rr * gg[2], o[3] * rr * gg[3]); o0.z = pk2(o[4] * rr * gg[4], o[5] * rr * gg[5]); o0.w = pk2(o[6] * rr * gg[6], o[7] * rr * gg[7]);
    o1.x = pk2(o[8] * rr * gg[8], o[9] * rr * gg[9]); o1.y = pk2(o[10] * rr * gg[10], o[11] * rr * gg[11]); o1.z = pk2(o[12] * rr * gg[12], o[13] * rr * gg[13]); o1.w = pk2(o[14] * rr * gg[14], o[15] * rr * gg[15]);
    bf16_t* dst = mix + (size_t)t * 2048 + 1024 + lane * 16;
    *(u32x4*)dst = o0; *(u32x4*)(dst + 8) = o1;
}

constexpr int MLA_LDS = (64 * 196 * 2 + 64 * 128 + 8 * 512) * 4;
__device__ __forceinline__ void st8f(LAS float* d, u32x4 v) { d[0] = bflo(v.x); d[1] = bfhi(v.x); d[2] = bflo(v.y); d[3] = bfhi(v.y); d[4] = bflo(v.z); d[5] = bfhi(v.z); d[6] = bflo(v.w); d[7] = bfhi(v.w); }
__global__ void __launch_bounds__(512) k_mla(const bf16_t* __restrict__ Q, const bf16_t* __restrict__ Kn, const bf16_t* __restrict__ Vv, const bf16_t* __restrict__ kpe, bf16_t* __restrict__ mix) {
    extern __shared__ __attribute__((aligned(16))) unsigned char lds[];
    LAS float* Qs = (LAS float*)lds; LAS float* Ks = Qs + 64 * 196; LAS float* Vs = Ks + 64 * 196; LAS float* Pt = Vs + 64 * 128;
    const int tid = threadIdx.x, lane = tid & 63, w = tid >> 6;
    const int qb = blockIdx.x, hd = blockIdx.y, b = blockIdx.z;
    const size_t t0 = (size_t)b * 2048 + qb * 64;
    for (int i = tid; i < 64 * 24; i += 512) { const int r = i / 24, ch = i % 24; st8f(Qs + r * 196 + ch * 8, *(const u32x4*)(Q + (t0 + r) * 1536 + hd * 192 + ch * 8)); }
    float m[8], l[8], o0[8], o1[8];
#pragma unroll
    for (int i = 0; i < 8; ++i) { m[i] = -INFINITY; l[i] = 0.f; o0[i] = 0.f; o1[i] = 0.f; }
    LAS float* P = Pt + w * 512;
    for (int kt = 0; kt < 32; ++kt) {
        __syncthreads();
        const size_t k0 = (size_t)b * 2048 + kt * 64;
        for (int i = tid; i < 64 * 24; i += 512) { const int r = i / 24, ch = i % 24;
            const bf16_t* src = ch < 16 ? Kn + (k0 + r) * 1024 + hd * 128 + ch * 8 : kpe + (k0 + r) * 64 + (ch - 16) * 8;
            st8f(Ks + r * 196 + ch * 8, *(const u32x4*)src); }
        for (int i = tid; i < 64 * 16; i += 512) { const int r = i / 16, ch = i % 16; st8f(Vs + r * 128 + ch * 8, *(const u32x4*)(Vv + (k0 + r) * 1024 + hd * 128 + ch * 8)); }
        __syncthreads();
#pragma unroll
        for (int qi = 0; qi < 8; ++qi) {
            const LAS f32x4* qp = (const LAS f32x4*)(Qs + (w * 8 + qi) * 196); const LAS f32x4* kp = (const LAS f32x4*)(Ks + lane * 196);
            float s = 0.f;
#pragma unroll 8
            for (int d = 0; d < 48; ++d) { const f32x4 a = qp[d], k = kp[d]; s += a.x * k.x + a.y * k.y + a.z * k.z + a.w * k.w; }
            const float mx = wave_max(s), mn = fmaxf(m[qi], mx), alpha = __expf(m[qi] - mn), p = __expf(s - mn), ps = wave_sum(p);
            l[qi] = l[qi] * alpha + ps; m[qi] = mn; o0[qi] *= alpha; o1[qi] *= alpha;
            P[lane * 8 + qi] = p;
        }
        for (int key = 0; key < 64; ++key) {
            const f32x4 pa = *(const LAS f32x4*)(P + key * 8), pb = *(const LAS f32x4*)(P + key * 8 + 4);
            const float v0 = Vs[key * 128 + lane], v1 = Vs[key * 128 + 64 + lane];
            o0[0] += pa.x * v0; o1[0] += pa.x * v1; o0[1] += pa.y * v0; o1[1] += pa.y * v1; o0[2] += pa.z * v0; o1[2] += pa.z * v1; o0[3] += pa.w * v0; o1[3] += pa.w * v1;
            o0[4] += pb.x * v0; o1[4] += pb.x * v1; o0[5] += pb.y * v0; o1[5] += pb.y * v1; o0[6] += pb.z * v0; o1[6] += pb.z * v1; o0[7] += pb.w * v0; o1[7] += pb.w * v1;
        }
    }
#pragma unroll
    for (int qi = 0; qi < 8; ++qi) { const float il = 1.0f / l[qi]; bf16_t* dst = mix + (t0 + w * 8 + qi) * 2048 + hd * 128;
        dst[lane] = (bf16_t)f2bf(o0[qi] * il); dst[64 + lane] = (bf16_t)f2bf(o1[qi] * il); }
}

constexpr int PEER_LDS = 65536 + 8 * 2048;
__device__ __forceinline__ void top16_2(float v0, float v1, int lane, float& tv, int& ti) {
    tv = 0.f; ti = 0;
    for (int k = 0; k < 16; ++k) {
        const float m = wave_max(fmaxf(v0, v1));
        const unsigned long long b0 = __ballot(v0 == m);
        int n;
        if (b0) { const int l = __builtin_ctzll(b0); n = l; if (lane == l) v0 = -INFINITY; }
        else { const unsigned long long b1 = __ballot(v1 == m); const int l = b1 ? __builtin_ctzll(b1) : 0; n = 64 + l; if (lane == l) v1 = -INFINITY; }
        if (lane == k) { tv = m; ti = n; }
    }
}
__global__ void __launch_bounds__(512) k_peer(const bf16_t* __restrict__ pq, const unsigned* __restrict__ KT, const bf16_t* __restrict__ U, const bf16_t* __restrict__ V,
                                             float* __restrict__ x32, bf16_t* __restrict__ h, const float* __restrict__ gain_next, float* __restrict__ out_final) {
    extern __shared__ __attribute__((aligned(16))) unsigned char lds[];
    LAS unsigned* kt = (LAS unsigned*)lds;
    const int tid = threadIdx.x, lane = tid & 63, w = tid >> 6;
    LAS unsigned* qbuf = (LAS unsigned*)(lds + 65536 + w * 2048); LAS int* idxs = (LAS int*)(qbuf + 128); LAS float* gs = (LAS float*)(qbuf + 256);
    for (int i = tid; i < 16384; i += 512) kt[i] = KT[i];
    __syncthreads();
    for (int t = blockIdx.x * 8 + w; t < T; t += gridDim.x * 8) {
        for (int hd = 0; hd < 8; ++hd) {
            const unsigned* qrow = (const unsigned*)(pq + (size_t)t * 2048 + hd * 256);
            qbuf[lane] = qrow[lane]; qbuf[lane + 64] = qrow[lane + 64];
            float s1a = 0.f, s1b = 0.f, s2a = 0.f, s2b = 0.f;
#pragma unroll 4
            for (int dp = 0; dp < 64; ++dp) { const unsigned q1 = qbuf[dp], q2 = qbuf[64 + dp];
                s1a = dot2(kt[dp * 128 + lane], q1, s1a); s1b = dot2(kt[dp * 128 + 64 + lane], q1, s1b);
                s2a = dot2(kt[8192 + dp * 128 + lane], q2, s2a); s2b = dot2(kt[8192 + dp * 128 + 64 + lane], q2, s2b); }
            float tv1, tv2; int ti1, ti2;
            top16_2(s1a, s1b, lane, tv1, ti1); top16_2(s2a, s2b, lane, tv2, ti2);
            const float va = __shfl(tv1, lane >> 2); const int ia = __shfl(ti1, lane >> 2);
            float c0 = va + __shfl(tv2, 4 * (lane & 3)), c1 = va + __shfl(tv2, 4 * (lane & 3) + 1), c2 = va + __shfl(tv2, 4 * (lane & 3) + 2), c3 = va + __shfl(tv2, 4 * (lane & 3) + 3);
            const int e0 = ia * 128 + __shfl(ti2, 4 * (lane & 3)), e1 = ia * 128 + __shfl(ti2, 4 * (lane & 3) + 1), e2 = ia * 128 + __shfl(ti2, 4 * (lane & 3) + 2), e3 = ia * 128 + __shfl(ti2, 4 * (lane & 3) + 3);
            for (int k = 0; k < 16; ++k) {
                const float mm = wave_max(fmaxf(fmaxf(c0, c1), fmaxf(c2, c3)));
                const unsigned long long bb = __ballot(c0 == mm || c1 == mm || c2 == mm || c3 == mm);
                const int ls = bb ? __builtin_ctzll(bb) : 0;
                if (lane == ls) { int e;
                    if (c0 == mm) { e = e0; c0 = -INFINITY; } else if (c1 == mm) { e = e1; c1 = -INFINITY; } else if (c2 == mm) { e = e2; c2 = -INFINITY; } else { e = e3; c3 = -INFINITY; }
                    idxs[hd * 16 + k] = e; gs[hd * 16 + k] = mm; }
            }
            if (lane < 16) {
                const float sc = gs[hd * 16 + lane], mx = gs[hd * 16]; const float e = __expf(sc - mx);
                float sum = e; sum += __shfl_xor(sum, 1); sum += __shfl_xor(sum, 2); sum += __shfl_xor(sum, 4); sum += __shfl_xor(sum, 8);
                gs[hd * 16 + lane] = e / sum; }
        }
        u32x4 hv[4];
#pragma unroll
        for (int j = 0; j < 4; ++j) hv[j] = *(const u32x4*)(h + (size_t)t * D + j * 512 + lane * 8);
        float y[32];
#pragma unroll
        for (int i = 0; i < 32; ++i) y[i] = 0.f;
#pragma unroll 2
        for (int k = 0; k < 128; ++k) {
            const int e = __builtin_amdgcn_readfirstlane(idxs[k]); const float g = gs[k];
            const bf16_t* urow = U + (size_t)e * D; const bf16_t* vrow = V + (size_t)e * D;
            u32x4 uv[4], vv[4];
#pragma unroll
            for (int j = 0; j < 4; ++j) { uv[j] = *(const u32x4*)(urow + j * 512 + lane * 8); vv[j] = *(const u32x4*)(vrow + j * 512 + lane * 8); }
            float p = 0.f;
#pragma unroll
            for (int j = 0; j < 4; ++j) { p = dot2(uv[j].x, hv[j].x, p); p = dot2(uv[j].y, hv[j].y, p); p = dot2(uv[j].z, hv[j].z, p); p = dot2(uv[j].w, hv[j].w, p); }
            p = wave_sum(p);
            const float a = 0.5f * p * (1.0f + erff(p * 0.70710678118654752f)) * g;
#pragma unroll
            for (int j = 0; j < 4; ++j) {
                y[j * 8 + 0] += a * bflo(vv[j].x); y[j * 8 + 1] += a * bfhi(vv[j].x); y[j * 8 + 2] += a * bflo(vv[j].y); y[j * 8 + 3] += a * bfhi(vv[j].y);
                y[j * 8 + 4] += a * bflo(vv[j].z); y[j * 8 + 5] += a * bfhi(vv[j].z); y[j * 8 + 6] += a * bflo(vv[j].w); y[j * 8 + 7] += a * bfhi(vv[j].w); }
        }
        float* xr = x32 + (size_t)t * D; float ss = 0.f;
#pragma unroll
        for (int j = 0; j < 4; ++j) { const f32x4 a = *(const f32x4*)(xr + j * 512 + lane * 8), b = *(const f32x4*)(xr + j * 512 + lane * 8 + 4);
            y[j * 8 + 0] += a.x; y[j * 8 + 1] += a.y; y[j * 8 + 2] += a.z; y[j * 8 + 3] += a.w; y[j * 8 + 4] += b.x; y[j * 8 + 5] += b.y; y[j * 8 + 6] += b.z; y[j * 8 + 7] += b.w; }
#pragma unroll
        for (int i = 0; i < 32; ++i) ss += y[i] * y[i];
        const float r = 1.0f / sqrtf(wave_sum(ss) * (1.0f / D) + EPS);
#pragma unroll
        for (int j = 0; j < 4; ++j) {
            const f32x4 g0 = *(const f32x4*)(gain_next + j * 512 + lane * 8), g1 = *(const f32x4*)(gain_next + j * 512 + lane * 8 + 4);
            if (out_final) {
                f32x4 a, b; a.x = y[j * 8] * r * g0.x; a.y = y[j * 8 + 1] * r * g0.y; a.z = y[j * 8 + 2] * r * g0.z; a.w = y[j * 8 + 3] * r * g0.w;
                b.x = y[j * 8 + 4] * r * g1.x; b.y = y[j * 8 + 5] * r * g1.y; b.z = y[j * 8 + 6] * r * g1.z; b.w = y[j * 8 + 7] * r * g1.w;
                *(f32x4*)(out_final + (size_t)t * D + j * 512 + lane * 8) = a; *(f32x4*)(out_final + (size_t)t * D + j * 512 + lane * 8 + 4) = b;
            } else {
                f32x4 a, b; a.x = y[j * 8]; a.y = y[j * 8 + 1]; a.z = y[j * 8 + 2]; a.w = y[j * 8 + 3]; b.x = y[j * 8 + 4]; b.y = y[j * 8 + 5]; b.z = y[j * 8 + 6]; b.w = y[j * 8 + 7];
                *(f32x4*)(xr + j * 512 + lane * 8) = a; *(f32x4*)(xr + j * 512 + lane * 8 + 4) = b;
                u32x4 o; o.x = pk2(a.x * r * g0.x, a.y * r * g0.y); o.y = pk2(a.z * r * g0.z, a.w * r * g0.w); o.z = pk2(b.x * r * g1.x, b.y * r * g1.y); o.w = pk2(b.z * r * g1.z, b.w * r * g1.w);
                *(u32x4*)(h + (size_t)t * D + j * 512 + lane * 8) = o;
            }
        }
    }
}

constexpr size_t MiB = 1u << 20;
constexpr size_t WS_WIN = 4 * MiB, WS_WUQ = WS_WIN + 64 * MiB, WS_WUKV = WS_WUQ + 6 * MiB, WS_WOUT = WS_WUKV + 4 * MiB, WS_WPQ = WS_WOUT + 32 * MiB,
                 WS_U = WS_WPQ + 32 * MiB, WS_V = WS_U + 256 * MiB, WS_KT = WS_V + 256 * MiB, WS_ROPE = WS_KT + 1 * MiB, WS_X32 = WS_ROPE + 1 * MiB,
                 WS_H = WS_X32 + 128 * MiB, WS_CQ = WS_H + 64 * MiB, WS_CKV = WS_CQ + 16 * MiB, WS_KPE = WS_CKV + 8 * MiB, WS_NQ = WS_KPE + 2 * MiB,
                 WS_NK = WS_NQ + 32 * MiB, WS_NV = WS_NK + 32 * MiB, WS_CQN = WS_NV + 32 * MiB, WS_CKVN = WS_CQN + 16 * MiB, WS_Q = WS_CKVN + 8 * MiB,
                 WS_KN = WS_Q + 48 * MiB, WS_VV = WS_KN + 32 * MiB, WS_MIX = WS_VV + 32 * MiB, WS_PQ = WS_MIX + 64 * MiB, WS_END = WS_PQ + 64 * MiB;

extern "C" void kernel_launch(void* const* d_in, const int* in_sizes, int n_in, void* d_out, int out_size, void* d_ws, size_t ws_size, hipStream_t stream) {
    if (n_in != 17 || ws_size < WS_END) { fprintf(stderr, "kernel_launch: unexpected n_in %d / ws_size %zu (need %zu)\n", n_in, ws_size, (size_t)WS_END); return; }
    const float* x = (const float*)d_in[0]; const float* attn_norm = (const float*)d_in[1]; const float* w_in = (const float*)d_in[2];
    const float* q_norm = (const float*)d_in[3]; const float* w_uq = (const float*)d_in[4]; const float* kv_norm = (const float*)d_in[5]; const float* w_ukv = (const float*)d_in[6];
    const float* rpb = (const float*)d_in[7]; const float* mla_on = (const float*)d_in[8]; const float* nat_on = (const float*)d_in[9]; const float* w_out = (const float*)d_in[10];
    const float* ffn_norm = (const float*)d_in[11]; const float* w_pq = (const float*)d_in[12]; const float* sub_keys = (const float*)d_in[13];
    const float* pu = (const float*)d_in[14]; const float* pv = (const float*)d_in[15]; const float* final_norm = (const float*)d_in[16];
    unsigned char* ws = (unsigned char*)d_ws;
    bf16_t* WinT = (bf16_t*)(ws + WS_WIN); bf16_t* WuqT = (bf16_t*)(ws + WS_WUQ); bf16_t* WukvT = (bf16_t*)(ws + WS_WUKV); bf16_t* WoutT = (bf16_t*)(ws + WS_WOUT); bf16_t* WpqT = (bf16_t*)(ws + WS_WPQ);
    bf16_t* Ub = (bf16_t*)(ws + WS_U); bf16_t* Vb = (bf16_t*)(ws + WS_V); unsigned* KT = (unsigned*)(ws + WS_KT); float* rope = (float*)(ws + WS_ROPE);
    float* x32 = (float*)(ws + WS_X32); bf16_t* h = (bf16_t*)(ws + WS_H); bf16_t* cq = (bf16_t*)(ws + WS_CQ); bf16_t* ckv = (bf16_t*)(ws + WS_CKV); bf16_t* kpe = (bf16_t*)(ws + WS_KPE);
    bf16_t* nq = (bf16_t*)(ws + WS_NQ); bf16_t* nk = (bf16_t*)(ws + WS_NK); bf16_t* nv = (bf16_t*)(ws + WS_NV); bf16_t* cqn = (bf16_t*)(ws + WS_CQN); bf16_t* ckvn = (bf16_t*)(ws + WS_CKVN);
    bf16_t* Q = (bf16_t*)(ws + WS_Q); bf16_t* Kn = (bf16_t*)(ws + WS_KN); bf16_t* mix = (bf16_t*)(ws + WS_MIX); bf16_t* pq = (bf16_t*)(ws + WS_PQ);
    static bool attr = false;
    if (!attr) { attr = true;
        (void)hipFuncSetAttribute((const void*)k_gemm<EpiIn>, hipFuncAttributeMaxDynamicSharedMemorySize, 131072);
        (void)hipFuncSetAttribute((const void*)k_gemm<EpiQ>, hipFuncAttributeMaxDynamicSharedMemorySize, 131072);
        (void)hipFuncSetAttribute((const void*)k_gemm<EpiResid>, hipFuncAttributeMaxDynamicSharedMemorySize, 131072);
        (void)hipFuncSetAttribute((const void*)k_gemm<pg8::EpiBf16<0>>, hipFuncAttributeMaxDynamicSharedMemorySize, 131072);
        (void)hipFuncSetAttribute((const void*)k_mla, hipFuncAttributeMaxDynamicSharedMemorySize, MLA_LDS);
        (void)hipFuncSetAttribute((const void*)k_peer, hipFuncAttributeMaxDynamicSharedMemorySize, PEER_LDS);
    }
    k_conv_wT<<<dim3(DINP / 32, D / 32, NL), 256, 0, stream>>>(w_in, WinT, D, DIN, DINP, 0);
    k_conv_wT<<<dim3(1536 / 32, 512 / 32, NL), 256, 0, stream>>>(w_uq, WuqT, 512, 1536, 1536, 1);
    k_conv_wT<<<dim3(2048 / 32, 256 / 32, NL), 256, 0, stream>>>(w_ukv, WukvT, 256, 2048, 2048, 2);
    k_conv_wT<<<dim3(64, 64, NL), 256, 0, stream>>>(w_out, WoutT, D, D, D, 3);
    k_conv_wT<<<dim3(64, 64, NL), 256, 0, stream>>>(w_pq, WpqT, D, D, D, 3);
    k_conv_bf16<<<8192, 256, 0, stream>>>(pu, Ub, (size_t)NL * 16384 * D / 8);
    k_conv_bf16<<<8192, 256, 0, stream>>>(pv, Vb, (size_t)NL * 16384 * D / 8);
    k_conv_keys<<<NL * 2 * 64 * 128 / 256, 256, 0, stream>>>(sub_keys, KT);
    k_rope_tab<<<SEQ * 32 / 256, 256, 0, stream>>>(rope);
    k_norm_x<<<T / 4, 256, 0, stream>>>(x, attn_norm, h, x32);
    const float qscale = 0.07216878364870322f;
    for (int l = 0; l < NL; ++l) {
        { pg8::Gemm g{h, WinT + (size_t)l * DINP * D, T, DINP, D, 0}; EpiIn E{cq, ckv, nq, nk, nv, kpe, rope};
          k_gemm<EpiIn><<<256, 512, 131072, stream>>>(g, E); }
        k_lat_norm<<<T / 4, 256, 0, stream>>>(cq, ckv, q_norm + l * 512, kv_norm + l * 256, cqn, ckvn);
        { pg8::Gemm g{cqn, WuqT + (size_t)l * 1536 * 512, T, 1536, 512, 0}; EpiQ E{Q, rope, qscale, 0};
          k_gemm<EpiQ><<<256, 512, 131072, stream>>>(g, E); }
        { pg8::Gemm g{ckvn, WukvT + (size_t)l * 2048 * 256, T, 2048, 256, 0}; pg8::EpiBf16<0> E{Kn, nullptr, (size_t)T * 1024, 1024, 1024};
          k_gemm<pg8::EpiBf16<0>><<<256, 512, 131072, stream>>>(g, E); }
        k_nat<<<T / 4, 256, 0, stream>>>(nq, nk, nv, rpb + (size_t)l * 16 * 15 * 31, nat_on + l * 1024, mix);
        k_mla<<<dim3(32, 8, 8), 512, MLA_LDS, stream>>>(Q, Kn, Kn + (size_t)T * 1024, kpe, mix);
        k_mla_norm<<<T / 4, 256, 0, stream>>>(mix, mla_on + l * 1024);
        { pg8::Gemm g{mix, WoutT + (size_t)l * D * D, T, D, D, 0}; EpiResid E{x32};
          k_gemm<EpiResid><<<256, 512, 131072, stream>>>(g, E); }
        k_norm_x<<<T / 4, 256, 0, stream>>>(x32, ffn_norm + l * D, h, nullptr);
        { pg8::Gemm g{h, WpqT + (size_t)l * D * D, T, D, D, 0}; pg8::EpiBf16<0> E{pq, nullptr, 0, D, 0};
          k_gemm<pg8::EpiBf16<0>><<<256, 512, 131072, stream>>>(g, E); }
        k_peer<<<512, 512, PEER_LDS, stream>>>(pq, KT + (size_t)l * 16384, Ub + (size_t)l * 16384 * D, Vb + (size_t)l * 16384 * D, x32, h,
                                             l == NL - 1 ? final_norm : attn_norm + (l + 1) * D, l == NL - 1 ? (float*)d_out : nullptr);
    }
}
```

```cpp
#include <cstdio>
#include <cstdint>
#include <hip/hip_runtime.h>
namespace pg8 {
#define PG8_LAS __attribute__((address_space(3)))
typedef unsigned short bf16_t;
typedef short bf16x8 __attribute__((ext_vector_type(8)));
typedef float f32x4 __attribute__((ext_vector_type(4)));
typedef unsigned u32x4 __attribute__((ext_vector_type(4)));
constexpr int BM = 256, BK = 64, HALF = 128, HTB = HALF * BK * 2  , STAGE_BYTES = 8 * HTB, NXCD = 8, WGM = 4;

__host__ __device__ __forceinline__ int lds_byte(int r, int c) { const int st = (r >> 4) * 2 + (c >> 5), rr = r & 15, cc = c & 31, ob = rr * 64 + cc * 2; return st * 1024 + (ob ^ (((ob >> 9) & 1) << 5)); }
__host__ __device__ __forceinline__ void stage_rc(int b, int& R, int& C) { const int st = b / 1024, sb = b % 1024, swz = sb ^ (((sb >> 9) & 1) << 5); R = (st >> 1) * 16 + swz / 64; C = (st & 1) * 32 + (swz % 64) / 2; }
__host__ __device__ __forceinline__ int perm32(int rho) { const int n = rho >> 4, i = rho & 15; return 8 * (i >> 2) + 4 * n + (i & 3); }

struct Unit { int pm, pn; };
struct Gemm { const bf16_t* A; const bf16_t* Bt; int M, N, K, pad; };

struct StaticOrder {
    int nM, nN, nwg, G, c;
    __host__ __device__ void init(int M, int N, int G_, int c_) { nM = M / BM; nN = N / BM; nwg = nM * nN; G = G_; c = c_; }
    __host__ __device__ bool next(int i, Unit& u) const {
        const long L = (long)i * G + c; if (L >= nwg) return false;
        int wgid = (int)L; { const int q = nwg / NXCD, r = nwg % NXCD, xcd = wgid % NXCD, off = wgid / NXCD; wgid = (xcd < r ? xcd * (q + 1) : r * (q + 1) + (xcd - r) * q) + off; }
        const int nig = WGM * nN, gid = wgid / nig, fm = gid * WGM, gsz = (nM - fm) < WGM ? (nM - fm) : WGM;
        u.pm = fm + ((wgid % nig) % gsz); u.pn = (wgid % nig) / gsz; return true;
    }
    __device__ __forceinline__ void a_ready(const Unit&) const {}
    __device__ __forceinline__ void done(const Unit&) const {}
};
struct CountedOrder : StaticOrder {
    const unsigned* ready; unsigned need; unsigned* tmo;
    __device__ __forceinline__ void a_ready(const Unit& u) const {
        if (threadIdx.x < 64) {
            const unsigned long long t0 = __builtin_amdgcn_s_memrealtime(); unsigned polls = 0;
            while ((unsigned)__builtin_amdgcn_readfirstlane(__hip_atomic_load(ready + 64 * u.pm, __ATOMIC_RELAXED, __HIP_MEMORY_SCOPE_AGENT)) < need) {
                if ((++polls & 255u) == 0u && __builtin_amdgcn_readfirstlane(__hip_atomic_load(tmo, __ATOMIC_RELAXED, __HIP_MEMORY_SCOPE_AGENT)) != 0u) break;
                if (__builtin_amdgcn_s_memrealtime() - t0 > 2000000ull) {
                    if (threadIdx.x == 0) { unsigned expect = 0u; __hip_atomic_compare_exchange_strong(tmo + 1, &expect, 0x600u | (unsigned)(u.pm & 0xff), __ATOMIC_RELAXED, __ATOMIC_RELAXED, __HIP_MEMORY_SCOPE_AGENT); __hip_atomic_store(tmo, 1u, __ATOMIC_RELAXED, __HIP_MEMORY_SCOPE_AGENT); }
                    break; }
                __builtin_amdgcn_s_sleep(2); }
            __builtin_amdgcn_fence(__ATOMIC_ACQUIRE, "agent");
            asm volatile("s_waitcnt vmcnt(0)" ::: "memory");
        }
#if !defined(BROKEN_HOOK_NO_BARRIER)
        asm volatile("" ::: "memory"); __builtin_amdgcn_s_barrier(); asm volatile("" ::: "memory");
#endif
    }
};

typedef __bf16 cvt_pk_bf16_b2 __attribute__((ext_vector_type(2))); typedef float cvt_pk_bf16_f2 __attribute__((ext_vector_type(2)));
__device__ __forceinline__ unsigned cvt_pk_bf16(float lo, float hi) { const cvt_pk_bf16_f2 v = {lo, hi}; return __builtin_bit_cast(unsigned, __builtin_convertvector(v, cvt_pk_bf16_b2)); }
typedef float f32x2 __attribute__((ext_vector_type(2)));
__device__ __forceinline__ f32x2 gelu_pk(f32x2 v) {
    const f32x2 av = __builtin_elementwise_abs(v), d = av * 0.2316418882f + 1.0f;
    f32x2 t; t.x = __builtin_amdgcn_rcpf(d.x); t.y = __builtin_amdgcn_rcpf(d.y);
    f32x2 q = t * 0.5307027145f + (-0.7265760135f); q = q * t + 0.7107068705f; q = q * t + (-0.142248368f); q = q * t + 0.127414796f; q = q * t;
    const f32x2 s = (v * v) * (-0.72134752044f);
    f32x2 e; e.x = __builtin_amdgcn_exp2f(s.x); e.y = __builtin_amdgcn_exp2f(s.y);
    const f32x2 m = v * (q * e), r = v - m;
    f32x2 o; o.x = v.x < 0.f ? m.x : r.x; o.y = v.y < 0.f ? m.y : r.y; return o;
}

struct EpiF32 {
    static constexpr bool PERM = false, AFTER_DRAIN = false;
    float* C; int ldc; const float* bias;
    __device__ __forceinline__ void operator()(const f32x4 (&acc)[2][2][4][2], const Unit& u, int wr, int wc, int fr, int fq) const {
        const int row0 = u.pm * BM + wr * 64 + fr, col0 = u.pn * BM + wc * 32 + 4 * fq;
        f32x4 bv[2][2];
#pragma unroll
        for (int bj = 0; bj < 2; ++bj)
#pragma unroll
            for (int n = 0; n < 2; ++n) bv[bj][n] = bias ? *(const f32x4*)(bias + col0 + bj * HALF + n * 16) : (f32x4){0.f, 0.f, 0.f, 0.f};
#pragma unroll
        for (int ai = 0; ai < 2; ++ai)
#pragma unroll
            for (int m = 0; m < 4; ++m) { float* rowp = C + (size_t)(row0 + ai * HALF + m * 16) * ldc + col0;
#pragma unroll
                for (int bj = 0; bj < 2; ++bj)
#pragma unroll
                    for (int n = 0; n < 2; ++n) *(f32x4*)(rowp + bj * HALF + n * 16) = acc[ai][bj][m][n] + bv[bj][n]; }
    }
};
template <int ACT  > struct EpiBf16 {
    static constexpr bool PERM = true, AFTER_DRAIN = false;
    bf16_t* O; const float* bias; size_t split_stride; int ldc; int split_cols;
    __device__ __forceinline__ void operator()(const f32x4 (&acc)[2][2][4][2], const Unit& u, int wr, int wc, int fr, int fq) const {
        const int row0 = u.pm * BM + wr * 64 + fr; int colt = u.pn * BM; bf16_t* base = O;
        if (split_cols) { const int t = colt / split_cols; base += (size_t)t * split_stride; colt -= t * split_cols; }
        const int col0 = colt + wc * 32 + 8 * fq, bcol0 = u.pn * BM + wc * 32 + 8 * fq;
        f32x4 bv[2][2];
#pragma unroll
        for (int bj = 0; bj < 2; ++bj)
#pragma unroll
            for (int n = 0; n < 2; ++n) bv[bj][n] = bias ? *(const f32x4*)(bias + bcol0 + bj * HALF + 4 * n) : (f32x4){0.f, 0.f, 0.f, 0.f};
#pragma unroll
        for (int ai = 0; ai < 2; ++ai)
#pragma unroll
            for (int m = 0; m < 4; ++m) { bf16_t* rowp = base + (size_t)(row0 + ai * HALF + m * 16) * ldc + col0;
#pragma unroll
                for (int bj = 0; bj < 2; ++bj) { f32x4 v0 = acc[ai][bj][m][0] + bv[bj][0], v1 = acc[ai][bj][m][1] + bv[bj][1];
                    if (ACT == 1) { f32x2 a = gelu_pk((f32x2){v0[0], v0[1]}), b = gelu_pk((f32x2){v0[2], v0[3]}), c = gelu_pk((f32x2){v1[0], v1[1]}), d = gelu_pk((f32x2){v1[2], v1[3]});
                        v0 = (f32x4){a.x, a.y, b.x, b.y}; v1 = (f32x4){c.x, c.y, d.x, d.y}; }
                    if (ACT == 2) {
#pragma unroll
                        for (int j = 0; j < 4; ++j) { v0[j] = 0.5f * v0[j] * (1.0f + erff(v0[j] * 0.70710678f)); v1[j] = 0.5f * v1[j] * (1.0f + erff(v1[j] * 0.70710678f)); } }
                    u32x4 w; w.x = cvt_pk_bf16(v0[0], v0[1]); w.y = cvt_pk_bf16(v0[2], v0[3]); w.z = cvt_pk_bf16(v1[0], v1[1]); w.w = cvt_pk_bf16(v1[2], v1[3]);
                    *(u32x4*)(rowp + bj * HALF) = w; } }
    }
};
template <class E, class = void> struct ord_of { static constexpr bool v = false; };
template <class E> struct ord_of<E, decltype((void)E::ORD)> { static constexpr bool v = E::ORD; };
template <class E, class = void> struct ksplit_of { static constexpr int v = 1; };
template <class E> struct ksplit_of<E, decltype((void)E::KSPLIT)> { static constexpr int v = E::KSPLIT; };
template <class Epi, class Sched, bool STAMP = false>
__device__ __forceinline__ void gemm_phase(PG8_LAS unsigned char* lds, const Gemm g, const Sched& S, const Epi& E, unsigned long long* stamps, int wave_in = -1) {
    int tid_raw;
    if (wave_in >= 0) { int ones_ = -1; asm volatile("" : "+s"(ones_)); tid_raw = wave_in * 64 + (int)__builtin_amdgcn_mbcnt_hi((unsigned)ones_, __builtin_amdgcn_mbcnt_lo((unsigned)ones_, 0u)); } else tid_raw = threadIdx.x;
    asm volatile("" : "+v"(tid_raw));
    const int tid = tid_raw, wid = __builtin_amdgcn_readfirstlane(tid >> 6), lane = tid & 63, wr = wid >> 2, wc = wid & 3, fr = lane & 15, fq = lane >> 4;
    constexpr int KS = ksplit_of<Epi>::v;
    const int K = g.K, nt = K / BK / KS;
    const size_t khstep = (size_t)(K / KS) * 2;
    int ts_lo = 0, ts_hi = 0, nts = 0; const unsigned long long rt_entry = STAMP ? (unsigned long long)wall_clock64() : 0ull;
#define PG8_STAMP() do { if (STAMP && wid == 0 && nts < 64) { const unsigned long long _c = (unsigned long long)clock64(); \
        ts_lo = (lane == nts) ? (int)(unsigned)_c : ts_lo; ts_hi = (lane == nts) ? (int)(unsigned)(_c >> 32) : ts_hi; ++nts; } } while (0)
    PG8_STAMP();
    unsigned voffA[2], voffB[2];
#pragma unroll
    for (int i = 0; i < 2; ++i) { int R, C; stage_rc(tid * 16 + i * 8192, R, C); const int Rb = Epi::PERM ? ((R & ~31) + perm32(R & 31)) : R;
        voffA[i] = (unsigned)(R * K + C) * 2u; voffB[i] = (unsigned)(Rb * K + C) * 2u; }
    const size_t kstep = (size_t)(BK * 2);
    const size_t hstep = (size_t)HALF * K * 2;
    const size_t tstep = 2 * hstep;
    const unsigned ldsw = (unsigned)wid * 1024u;
    const int aoff = lds_byte(wr * 64 + fr, fq * 8), boff = lds_byte(wc * 32 + fr, fq * 8);
#define PG8_SA(b, h) (((b) * 2 + (h)) * HTB)
#define PG8_SB(b, h) ((4 + (b) * 2 + (h)) * HTB)
#define PG8_STAGE(bufoff, gbase, voff) do { _Pragma("unroll") for (int _i = 0; _i < 2; ++_i) \
        __builtin_amdgcn_global_load_lds((const unsigned*)((const char*)(gbase) + (voff)[_i]), (PG8_LAS unsigned*)(lds + (bufoff) + ldsw + _i * 8192), 16, 0, 0); } while (0)
#define PG8_LDA(dst, b, h) do { _Pragma("unroll") for (int m = 0; m < 4; ++m) _Pragma("unroll") for (int k = 0; k < 2; ++k) dst[m][k] = *(const PG8_LAS bf16x8*)(lds + PG8_SA(b, h) + aoff + m * 2048 + k * 1024); } while (0)
#define PG8_LDB(dst, b, h) do { _Pragma("unroll") for (int n = 0; n < 2; ++n) _Pragma("unroll") for (int k = 0; k < 2; ++k) dst[n][k] = *(const PG8_LAS bf16x8*)(lds + PG8_SB(b, h) + boff + n * 2048 + k * 1024); } while (0)
#define PG8_MMA(ai, bj, At, Bt) do { __builtin_amdgcn_s_setprio(1); _Pragma("unroll") for (int m = 0; m < 4; ++m) _Pragma("unroll") for (int n = 0; n < 2; ++n) _Pragma("unroll") for (int k = 0; k < 2; ++k) \
        acc[ai][bj][m][n] = __builtin_amdgcn_mfma_f32_16x16x32_bf16(Bt[n][k], At[m][k], acc[ai][bj][m][n], 0, 0, 0); __builtin_amdgcn_s_setprio(0); } while (0)
#define PG8_WAIT_V(n) asm volatile("s_waitcnt vmcnt(" #n ")" ::: "memory")
#define PG8_WAIT_L(n) asm volatile("s_waitcnt lgkmcnt(" #n ")" ::: "memory")
#define PG8_BAR __builtin_amdgcn_s_barrier()
#define PG8_SCHED __builtin_amdgcn_sched_barrier(0)
    Unit cur, nxt; int ui = 0;
    if (!S.next(0, cur)) return;
    int kh = 0;
    f32x4 acc[2][2][4][2];
#pragma unroll
    for (int a = 0; a < 2; ++a)
#pragma unroll
        for (int b = 0; b < 2; ++b)
#pragma unroll
            for (int m = 0; m < 4; ++m)
#pragma unroll
                for (int n = 0; n < 2; ++n) acc[a][b][m][n] = (f32x4){0.f, 0.f, 0.f, 0.f};
    bf16x8 At[4][2], B0[2][2], B1[2][2];
    const char* cA = (const char*)g.A + (size_t)cur.pm * tstep; const char* cB = (const char*)g.Bt + (size_t)cur.pn * tstep;
    S.a_ready(cur);
    PG8_STAGE(PG8_SB(0, 0), cB, voffB); PG8_STAGE(PG8_SA(0, 0), cA, voffA); PG8_STAGE(PG8_SB(0, 1), cB + hstep, voffB); PG8_STAGE(PG8_SA(0, 1), cA + hstep, voffA);
    if (wr == 1) PG8_BAR;
    PG8_WAIT_V(4); PG8_BAR;
    PG8_STAGE(PG8_SB(1, 0), cB + kstep, voffB); PG8_STAGE(PG8_SA(1, 0), cA + kstep, voffA); PG8_STAGE(PG8_SB(1, 1), cB + hstep + kstep, voffB);
    PG8_WAIT_V(6); PG8_BAR;
    PG8_STAMP();
    for (;;) {
        const int kh_n = (ui + 1) % KS; const bool has_next = S.next((ui + 1) / KS, nxt);
        const char* nA = has_next ? (const char*)g.A + (size_t)nxt.pm * tstep + (size_t)kh_n * khstep : cA; const char* nB = has_next ? (const char*)g.Bt + (size_t)nxt.pn * tstep + (size_t)kh_n * khstep : cB;
        for (int t = 0; t < nt; t += 2) {
            const bool last = (t == nt - 2);
            const char* a1 = cA + (size_t)(t + 1) * kstep;
            const char* a2 = last ? nA : cA + (size_t)(t + 2) * kstep; const char* b2 = last ? nB : cB + (size_t)(t + 2) * kstep;
            const char* a3 = a2 + kstep; const char* b3 = b2 + kstep;
            if (last && has_next) S.a_ready(nxt);
            PG8_LDB(B0, 0, 0); PG8_SCHED; PG8_LDA(At, 0, 0); PG8_STAGE(PG8_SA(1, 1), a1 + hstep, voffA);
            PG8_WAIT_L(8); PG8_BAR; PG8_WAIT_L(0); PG8_MMA(0, 0, At, B0); PG8_BAR; PG8_SCHED;
            PG8_LDB(B1, 0, 1); PG8_STAGE(PG8_SB(0, 0), b2, voffB);
            PG8_BAR; PG8_WAIT_L(0); PG8_MMA(0, 1, At, B1); PG8_BAR;
            PG8_LDA(At, 0, 1); PG8_STAGE(PG8_SA(0, 0), a2, voffA);
            PG8_BAR; PG8_WAIT_L(0); PG8_MMA(1, 0, At, B0); PG8_BAR; PG8_SCHED;
            PG8_STAGE(PG8_SB(0, 1), b2 + hstep, voffB);
            PG8_WAIT_V(6); PG8_BAR; PG8_MMA(1, 1, At, B1); PG8_BAR;
            PG8_LDB(B0, 1, 0); PG8_SCHED; PG8_LDA(At, 1, 0); PG8_STAGE(PG8_SA(0, 1), a2 + hstep, voffA);
            PG8_WAIT_L(8); PG8_BAR; PG8_WAIT_L(0); PG8_MMA(0, 0, At, B0); PG8_BAR; PG8_SCHED;
            PG8_LDB(B1, 1, 1); PG8_STAGE(PG8_SB(1, 0), b3, voffB);
            PG8_BAR; PG8_WAIT_L(0); PG8_MMA(0, 1, At, B1); PG8_BAR;
            PG8_LDA(At, 1, 1); PG8_STAGE(PG8_SA(1, 0), a3, voffA);
            PG8_BAR; PG8_WAIT_L(0); PG8_MMA(1, 0, At, B0); PG8_BAR; PG8_SCHED;
            PG8_STAGE(PG8_SB(1, 1), b3 + hstep, voffB);
            PG8_WAIT_V(6); PG8_BAR; PG8_MMA(1, 1, At, B1); PG8_BAR;
        }
        PG8_STAMP();
        bool keep_acc = false;
        if constexpr (KS > 1) { if (kh + 1 < KS) { E.mid(acc, cur, wr, wc, fr, fq, ui / KS); keep_acc = true; } else { E(acc, cur, wr, wc, fr, fq, ui / KS); S.done(cur); } }
        else if constexpr (ord_of<Epi>::v) { E(acc, cur, wr, wc, fr, fq, ui); S.done(cur); }
        else if constexpr (!Epi::AFTER_DRAIN) { E(acc, cur, wr, wc, fr, fq); S.done(cur); }
        PG8_STAMP();
        if (!has_next) break;
        if (!keep_acc) {
#pragma unroll
        for (int a = 0; a < 2; ++a)
#pragma unroll
            for (int b = 0; b < 2; ++b)
#pragma unroll
                for (int m = 0; m < 4; ++m)
#pragma unroll
                    for (int n = 0; n < 2; ++n) acc[a][b][m][n] = (f32x4){0.f, 0.f, 0.f, 0.f}; }
        cur = nxt; cA = nA; cB = nB; ++ui; kh = kh_n;
    }
    PG8_WAIT_V(0);
    if (wr == 0) PG8_BAR;
    PG8_BAR;
    if constexpr (Epi::AFTER_DRAIN) { E.fused(acc, cur, wr, wc, fr, fq, lds, wid, lane); S.done(cur); }
    PG8_STAMP();
    if (STAMP && wid == 0) { stamps[lane] = lane < nts ? (((unsigned long long)(unsigned)ts_hi << 32) | (unsigned)ts_lo) : 0ull;
        if (lane == 62) stamps[62] = rt_entry; if (lane == 63) stamps[63] = (unsigned long long)wall_clock64(); }
#undef PG8_STAMP
#undef PG8_SA
#undef PG8_SB
#undef PG8_STAGE
#undef PG8_LDA
#undef PG8_LDB
#undef PG8_MMA
#undef PG8_WAIT_V
#undef PG8_WAIT_L
#undef PG8_BAR
#undef PG8_SCHED
}
}

#define LAS __attribute__((address_space(3)))
typedef unsigned short bf16_t;
typedef float f32x4 __attribute__((ext_vector_type(4)));
typedef unsigned u32x4 __attribute__((ext_vector_type(4)));
typedef unsigned u32x2 __attribute__((ext_vector_type(2)));
typedef __bf16 bf16x2 __attribute__((ext_vector_type(2)));

constexpr int T = 16384, D = 2048, SEQ = 2048, NL = 4;
constexpr int DIN = 3904, DINP = 4096;
constexpr float EPS = 1e-6f;

__device__ __forceinline__ unsigned f2bf(float f) { unsigned u = __float_as_uint(f); return (u + 0x7fffu + ((u >> 16) & 1u)) >> 16; }
__device__ __forceinline__ unsigned pk2(float lo, float hi) { return f2bf(lo) | (f2bf(hi) << 16); }
__device__ __forceinline__ float bflo(unsigned w) { return __uint_as_float(w << 16); }
__device__ __forceinline__ float bfhi(unsigned w) { return __uint_as_float(w & 0xffff0000u); }
__device__ __forceinline__ float wave_sum(float v) {
#pragma unroll
    for (int o = 1; o < 64; o <<= 1) v += __shfl_xor(v, o);
    return v; }
__device__ __forceinline__ float wave_max(float v) {
#pragma unroll
    for (int o = 1; o < 64; o <<= 1) v = fmaxf(v, __shfl_xor(v, o));
    return v; }
__device__ __forceinline__ float dot2(unsigned a, unsigned b, float acc) { return __builtin_amdgcn_fdot2_f32_bf16(__builtin_bit_cast(bf16x2, a), __builtin_bit_cast(bf16x2, b), acc, false); }

__device__ __forceinline__ int src_col(int mode, int n) {
    if (mode == 0) {
        if (n < 768) return n;
        if (n < 3840) return n + 64;
        if (n < 3904) { const int i = n - 3840; return 768 + (i >> 1) + 32 * (i & 1); }
        return -1;
    } else if (mode == 1) {
        const int h = n / 192, i = n % 192; if (i < 128) return n; const int ii = i - 128; return h * 192 + 128 + (ii >> 1) + 32 * (ii & 1);
    } else if (mode == 2) {
        if (n < 1024) { const int h = n >> 7, d = n & 127; return h * 256 + d; }
        const int m = n - 1024, h = m >> 7, d = m & 127; return h * 256 + 128 + d;
    }
    return n;
}
__device__ __forceinline__ void rope8(f32x4& v0, f32x4& v1, const float* __restrict__ tabrow, int j0) {
    const f32x4 c = *(const f32x4*)(tabrow + j0), s = *(const f32x4*)(tabrow + 32 + j0);
    f32x4 a, b;
    a.x = v0.x * c.x - v0.y * s.x; a.y = v0.y * c.x + v0.x * s.x; a.z = v0.z * c.y - v0.w * s.y; a.w = v0.w * c.y + v0.z * s.y;
    b.x = v1.x * c.z - v1.y * s.z; b.y = v1.y * c.z + v1.x * s.z; b.z = v1.z * c.w - v1.w * s.w; b.w = v1.w * c.w + v1.z * s.w;
    v0 = a; v1 = b;
}
struct EpiIn {
    static constexpr bool PERM = true, AFTER_DRAIN = false;
    bf16_t *cq, *ckv, *nq, *nk, *nv, *kpe; const float* rope; float* lp;
    __device__ __forceinline__ void operator()(const pg8::f32x4 (&acc)[2][2][4][2], const pg8::Unit& u, int wr, int wc, int fr, int fq) const {
        const int pn = u.pn, row0 = u.pm * 256 + wr * 64 + fr, cit = wc * 32 + 8 * fq;
        if (pn == 15) {
            if (wc < 2) {
#pragma unroll
                for (int ai = 0; ai < 2; ++ai)
#pragma unroll
                    for (int m = 0; m < 4; ++m) { const int row = row0 + ai * 128 + m * 16;
                        f32x4 v0 = acc[ai][0][m][0], v1 = acc[ai][0][m][1];
                        rope8(v0, v1, rope + (size_t)(row & (SEQ - 1)) * 64, cit >> 1);
                        u32x4 w; w.x = pk2(v0.x, v0.y); w.y = pk2(v0.z, v0.w); w.z = pk2(v1.x, v1.y); w.w = pk2(v1.z, v1.w);
                        *(u32x4*)(kpe + (size_t)row * 64 + cit) = w; }
            }
            return;
        }
        bf16_t* base; int ld, c0; float sc = 1.f;
        if (pn < 2) { base = cq; ld = 512; c0 = pn * 256; }
        else if (pn == 2) { base = ckv; ld = 256; c0 = 0; }
        else if (pn < 7) { base = nq; ld = 1024; c0 = (pn - 3) * 256; sc = 0.125f; }
        else if (pn < 11) { base = nk; ld = 1024; c0 = (pn - 7) * 256; }
        else { base = nv; ld = 1024; c0 = (pn - 11) * 256; }
#pragma unroll
        for (int ai = 0; ai < 2; ++ai)
#pragma unroll
            for (int m = 0; m < 4; ++m) { const int row = row0 + ai * 128 + m * 16; bf16_t* rowp = base + (size_t)row * ld + c0 + cit; float ss = 0.f;
#pragma unroll
                for (int bj = 0; bj < 2; ++bj) { const f32x4 v0 = acc[ai][bj][m][0] * sc, v1 = acc[ai][bj][m][1] * sc;
                    u32x4 w; w.x = pk2(v0.x, v0.y); w.y = pk2(v0.z, v0.w); w.z = pk2(v1.x, v1.y); w.w = pk2(v1.z, v1.w);
                    *(u32x4*)(rowp + bj * 128) = w;
                    if (pn < 3) {
#pragma unroll
                        for (int q = 0; q < 4; ++q) { const float lo = __uint_as_float(w[q] << 16), hi = __uint_as_float(w[q] & 0xffff0000u); ss += lo * lo + hi * hi; } } }
                if (pn < 3) { ss += __shfl_xor(ss, 16); ss += __shfl_xor(ss, 32); if (fq == 0) lp[(size_t)row * 16 + pn * 4 + wc] = ss; } }
    }
};
__device__ __forceinline__ float lat_scale(const float* p, int n, float dim) { float t = 0.f; for (int i = 0; i < n; ++i) t += p[i]; return 1.0f / sqrtf(t / dim + EPS); }
struct EpiQ {
    static constexpr bool PERM = true, AFTER_DRAIN = false, ORD = true;
    bf16_t* Q; const float* rope; const LAS float* tab; const float* lp; float qscale; int pad;
    __device__ __forceinline__ void operator()(const pg8::f32x4 (&acc)[2][2][4][2], const pg8::Unit& u, int wr, int wc, int fr, int fq, int ord) const {
        int rl0 = wr * 64 + fr; asm volatile("" : "+v"(rl0)); const int row0 = u.pm * 256 + rl0;
#pragma unroll
        for (int bj = 0; bj < 2; ++bj) {
            const int col = u.pn * 256 + bj * 128 + wc * 32 + 8 * fq, i = col % 192; const bool rp = i >= 128; const int j0 = (i - 128) >> 1;
#pragma unroll
            for (int ai = 0; ai < 2; ++ai)
#pragma unroll
                for (int m = 0; m < 4; ++m) { const int row = row0 + ai * 128 + m * 16; const float qs = qscale * (ord < 20 ? tab[ord * 256 + rl0 + ai * 128 + m * 16] : lat_scale(lp + (size_t)row * 16, 8, 512.0f));
                    f32x4 v0 = acc[ai][bj][m][0] * qs, v1 = acc[ai][bj][m][1] * qs;
                    if (rp) rope8(v0, v1, rope + (size_t)(row & (SEQ - 1)) * 64, j0);
                    u32x4 w; w.x = pk2(v0.x, v0.y); w.y = pk2(v0.z, v0.w); w.z = pk2(v1.x, v1.y); w.w = pk2(v1.z, v1.w);
                    *(u32x4*)(Q + (size_t)row * 1536 + col) = w; } }
    }
};
struct EpiResid {
    static constexpr bool PERM = false, AFTER_DRAIN = false;
    float* X;
    __device__ __forceinline__ void operator()(const pg8::f32x4 (&acc)[2][2][4][2], const pg8::Unit& u, int wr, int wc, int fr, int fq) const {
        const int row0 = u.pm * 256 + wr * 64 + fr, col0 = u.pn * 256 + wc * 32 + 4 * fq;
#pragma unroll
        for (int ai = 0; ai < 2; ++ai)
#pragma unroll
            for (int m = 0; m < 4; ++m) { float* rowp = X + (size_t)(row0 + ai * 128 + m * 16) * D + col0;
#pragma unroll
                for (int bj = 0; bj < 2; ++bj)
#pragma unroll
                    for (int n = 0; n < 2; ++n) { f32x4* p = (f32x4*)(rowp + bj * 128 + n * 16); *p = *p + acc[ai][bj][m][n]; } }
    }
};
#define XB_TMO      128
#define XB_XCNT(j)  (256  + 64 * (j))
#define XB_XSUB(j)  (1280 + 64 * (j))
#define XB_XGEN(j)  (2304 + 64 * (j))
#define XB_TOP      3328
#define XB_TOPGEN   3392
#define XCD_BAR_WORDS 3456
#define XB_SPIN_CAP (1u << 22)
#define LAS __attribute__((address_space(3)))

__device__ __forceinline__ unsigned xb_ld(unsigned* p)              { return __hip_atomic_load(p, __ATOMIC_RELAXED, __HIP_MEMORY_SCOPE_AGENT); }
__device__ __forceinline__ unsigned xb_add(unsigned* p, unsigned v) { return __hip_atomic_fetch_add(p, v, __ATOMIC_RELAXED, __HIP_MEMORY_SCOPE_AGENT); }
__device__ __forceinline__ unsigned xb_xcc_id() { return (unsigned)__builtin_amdgcn_s_getreg((3 << 11) | 20) & 0xFu; }
#define XB_SPIN(cond, bar) do { unsigned _sp = 0; while (cond) { __builtin_amdgcn_s_sleep(1); \
    if ((++_sp & 255u) == 0u) { if (xb_ld(&(bar)[XB_TMO])) break; if (_sp > XB_SPIN_CAP) { atomicAdd(&(bar)[XB_TMO], 1u); break; } } } } while (0)

struct XcdBarrier {
    unsigned* bar; unsigned x;
    volatile LAS unsigned* st;
};

__device__ __forceinline__ XcdBarrier xcd_barrier_post(unsigned* bar, volatile LAS unsigned* st) {
    XcdBarrier b; b.bar = bar; b.x = xb_xcc_id(); b.st = st;
    if (threadIdx.x == 0) (void)xb_add(&bar[XB_XCNT(b.x)], 1u);
    return b;
}
__device__ __forceinline__ void xcd_barrier_complete(unsigned* bar, unsigned x, unsigned& nloc, unsigned& nx) {
    const unsigned G = gridDim.x * gridDim.y * gridDim.z;
    unsigned sum, cnt, mine, sp = 0u;
    for (;;) {
        sum = 0u; cnt = 0u; mine = 0u;
#pragma unroll
        for (unsigned j = 0; j < 16; ++j) { const unsigned c = xb_ld(&bar[XB_XCNT(j)]); sum += c; cnt += (c > 0u) ? 1u : 0u; mine = (j == x) ? c : mine; }
        if (sum == G) break;
        __builtin_amdgcn_s_sleep(1);
        if ((++sp & 255u) == 0u) { if (xb_ld(&bar[XB_TMO])) break; if (sp > XB_SPIN_CAP) { atomicAdd(&bar[XB_TMO], 1u); break; } }
    }
    nloc = mine > 0u ? mine : 1u; nx = cnt > 0u ? cnt : 1u;
}

__device__ __forceinline__ void xcd_barrier(const XcdBarrier& b, bool is_t0) {
    asm volatile("s_waitcnt vmcnt(0)" ::: "memory");
    __syncthreads();
    if (is_t0) {
        unsigned* bar = b.bar; unsigned bx = b.x; asm volatile("" : "+s"(bx));
        __builtin_amdgcn_s_waitcnt(0);
        unsigned nloc = b.st[0], nx = b.st[1];
        if (nloc == 0u) { xcd_barrier_complete(bar, bx, nloc, nx); b.st[0] = nloc; b.st[1] = nx; }
        const unsigned old = xb_add(&bar[XB_XSUB(bx)], 1u);
        const unsigned gen = old / nloc;
        if (old + 1u == (gen + 1u) * nloc) {
            __builtin_amdgcn_fence(__ATOMIC_RELEASE, "agent");
            asm volatile("s_waitcnt vmcnt(0)" ::: "memory");
            const unsigned og = xb_add(&bar[XB_TOP], 1u);
            const unsigned tg = og / nx;
            if (og + 1u == (tg + 1u) * nx) xb_add(&bar[XB_TOPGEN], 1u);
            else XB_SPIN(xb_ld(&bar[XB_TOPGEN]) == tg, bar);
            __builtin_amdgcn_fence(__ATOMIC_ACQUIRE, "agent");
            xb_add(&bar[XB_XGEN(bx)], 1u);
            asm volatile("s_waitcnt vmcnt(0)" ::: "memory");
        } else {
            XB_SPIN(xb_ld(&bar[XB_XGEN(bx)]) == gen, bar);
            __builtin_amdgcn_fence(__ATOMIC_ACQUIRE, "agent");
            asm volatile("s_waitcnt vmcnt(0)" ::: "memory");
        }
    }
    __syncthreads();
}

namespace mla {
using bf16x8 = __attribute__((ext_vector_type(8))) short;
using s16x4  = __attribute__((ext_vector_type(4))) short;
using f32x16 = __attribute__((ext_vector_type(16))) float;
using u32x4v = __attribute__((ext_vector_type(4))) unsigned;
constexpr int NW = 8, QBLK = 32, KVBLK = 64, DQK = 192, DV = 128;
constexpr float THR = 8.f;
constexpr int SHM_V = KVBLK * DV * 2, SHM_K = KVBLK * DQK * 2, SHM_ATTN = 3 * SHM_V + 2 * SHM_K + NW * 64 * 4;
#define MLA_KSWZ(row, colB) ((row) * 384 + ((colB) ^ (((row) & 7) << 4)))
#define MLA_SBAR() __builtin_amdgcn_sched_barrier(0)
__device__ __forceinline__ int crow(int r, int hi) { return (r & 3) + 8 * (r >> 2) + 4 * hi; }
__device__ __forceinline__ void half32_rowsum_store(const float (&v)[16], int lane, float* __restrict__ dst  , int stride) {
  const bool b4 = lane & 16, b3 = lane & 8, b2 = lane & 4, b1 = lane & 2; const int hi = lane >> 5;
  float w[8], x[4], y[2];
#pragma unroll
  for (int i = 0; i < 8; ++i) { const float send = b4 ? v[i] : v[i + 8], keep = b4 ? v[i + 8] : v[i]; w[i] = keep + __shfl_xor(send, 16); }
#pragma unroll
  for (int i = 0; i < 4; ++i) { const float send = b3 ? w[i] : w[i + 4], keep = b3 ? w[i + 4] : w[i]; x[i] = keep + __shfl_xor(send, 8); }
#pragma unroll
  for (int i = 0; i < 2; ++i) { const float send = b2 ? x[i] : x[i + 2], keep = b2 ? x[i + 2] : x[i]; y[i] = keep + __shfl_xor(send, 4); }
  float z; { const float send = b1 ? y[0] : y[1], keep = b1 ? y[1] : y[0]; z = keep + __shfl_xor(send, 2); }
  z += __shfl_xor(z, 1);
  const int r = (b4 ? 8 : 0) + (b3 ? 4 : 0) + (b2 ? 2 : 0) + (b1 ? 1 : 0);
  if (!(lane & 1)) dst[crow(r, hi) * stride] = z;
}
typedef __bf16 cvtpk_b2 __attribute__((ext_vector_type(2))); typedef float cvtpk_f2 __attribute__((ext_vector_type(2)));
__device__ __forceinline__ unsigned cvtpk(float lo, float hi) { const cvtpk_f2 v = {lo, hi}; return __builtin_bit_cast(unsigned, __builtin_convertvector(v, cvtpk_b2)); }
__device__ __forceinline__ void partialSM(f32x16& p0, f32x16& p1, float& m_reg, float& mn, float& alpha) {
  constexpr float C = 1.4426950408889634f;
  float pmax = p0[0];
#pragma unroll
  for (int r = 1; r < 16; ++r) pmax = fmaxf(pmax, p0[r]);
#pragma unroll
  for (int r = 0; r < 16; ++r) pmax = fmaxf(pmax, p1[r]);
  { auto rr = __builtin_amdgcn_permlane32_swap(__float_as_uint(pmax), __float_as_uint(pmax), false, false);
    pmax = fmaxf(__uint_as_float(rr[0]), __uint_as_float(rr[1])); }
  if (__builtin_expect(__all(pmax - m_reg <= THR), 1)) { mn = m_reg; alpha = 1.f; }
  else { mn = fmaxf(m_reg, pmax); alpha = __builtin_amdgcn_exp2f((m_reg - mn) * C); m_reg = mn; }
  float mnC = -mn * C;
#pragma unroll
  for (int r = 0; r < 16; ++r) p0[r] = fmaf(p0[r], C, mnC);
#pragma unroll
  for (int r = 0; r < 16; ++r) p1[r] = fmaf(p1[r], C, mnC);
#pragma unroll
  for (int r = 0; r < 16; ++r) p0[r] = __builtin_amdgcn_exp2f(p0[r]);
}
__device__ __forceinline__ void finishSM(f32x16& p0, f32x16& p1, float alpha, float& l_reg, bf16x8& pa0, bf16x8& pa1, bf16x8& pa2, bf16x8& pa3) {
#pragma unroll
  for (int r = 0; r < 16; ++r) p1[r] = __builtin_amdgcn_exp2f(p1[r]);
  float ps = 0;
#pragma unroll
  for (int r = 0; r < 16; ++r) ps += p0[r];
#pragma unroll
  for (int r = 0; r < 16; ++r) ps += p1[r];
  { auto rr = __builtin_amdgcn_permlane32_swap(__float_as_uint(ps), __float_as_uint(ps), false, false);
    ps = __uint_as_float(rr[0]) + __uint_as_float(rr[1]); }
  l_reg = l_reg * alpha + ps;
#define MLA_PK4(P, BASE, OUT) do { unsigned a0 = cvtpk(P[BASE + 0], P[BASE + 1]), a1 = cvtpk(P[BASE + 2], P[BASE + 3]);   \
    unsigned b0 = cvtpk(P[BASE + 4], P[BASE + 5]), b1 = cvtpk(P[BASE + 6], P[BASE + 7]);                              \
    auto r0 = __builtin_amdgcn_permlane32_swap(a0, b0, false, false); auto r1 = __builtin_amdgcn_permlane32_swap(a1, b1, false, false); \
    u32x4v w = {r0[0], r1[0], r0[1], r1[1]}; OUT = *reinterpret_cast<bf16x8*>(&w); } while (0)
  MLA_PK4(p0, 0, pa0); MLA_PK4(p0, 8, pa1); MLA_PK4(p1, 0, pa2); MLA_PK4(p1, 8, pa3);
#undef MLA_PK4
}
__device__ __forceinline__ void qkt(f32x16& p0, f32x16& p1, const LAS char* Ks, const bf16x8 (&qr)[12], int r32, int hi) {
  p0 = f32x16{}; p1 = f32x16{};
#pragma unroll
  for (int d0 = 0; d0 < 12; ++d0) { const int cb = (d0 * 16 + hi * 8) * 2;
    const bf16x8 b0 = *reinterpret_cast<const LAS bf16x8*>(Ks + MLA_KSWZ(r32, cb));
    const bf16x8 b1 = *reinterpret_cast<const LAS bf16x8*>(Ks + MLA_KSWZ(32 + r32, cb));
    p0 = __builtin_amdgcn_mfma_f32_32x32x16_bf16(b0, qr[d0], p0, 0, 0, 0);
    p1 = __builtin_amdgcn_mfma_f32_32x32x16_bf16(b1, qr[d0], p1, 0, 0, 0); }
}
__device__ __forceinline__ int v_st(int k, int c) { const int kk = (k & ~0xC) | ((k & 4) << 1) | ((k & 8) >> 1); return ((kk >> 3) * 4 + (c >> 5)) * 512 + ((kk & 7) * 32 + (c & 31)) * 2; }
__device__ __forceinline__ int v_rd_base(int lane) { return ((lane & 3) << 3) | (((lane >> 2) & 3) << 6) | (((lane >> 4) & 1) << 5) | (((lane >> 5) & 1) << 8); }
constexpr int v_rd_off(int d0, int ks, int half) { return d0 * 512 + ks * 4096 + half * 2048; }
template <int OFF> __device__ __forceinline__ s16x4 tr_read(int vb) {
  s16x4 r; asm volatile("ds_read_b64_tr_b16 %0, %1 offset:%2" : "=&v"(r) : "v"(vb), "i"(OFF) : "memory"); return r;
}
template <int D0> __device__ __forceinline__ void pv_one(f32x16& od, int vb, bf16x8 pa0, bf16x8 pa1, bf16x8 pa2, bf16x8 pa3) {
  const s16x4 l0 = tr_read<v_rd_off(D0, 0, 0)>(vb), h0 = tr_read<v_rd_off(D0, 0, 1)>(vb), l1 = tr_read<v_rd_off(D0, 1, 0)>(vb), h1 = tr_read<v_rd_off(D0, 1, 1)>(vb);
  const s16x4 l2 = tr_read<v_rd_off(D0, 2, 0)>(vb), h2 = tr_read<v_rd_off(D0, 2, 1)>(vb), l3 = tr_read<v_rd_off(D0, 3, 0)>(vb), h3 = tr_read<v_rd_off(D0, 3, 1)>(vb);
  asm volatile("s_waitcnt lgkmcnt(0)" ::: "memory"); MLA_SBAR();
#define MLA_PK(L, H) (bf16x8){L[0], L[1], L[2], L[3], H[0], H[1], H[2], H[3]}
  od = __builtin_amdgcn_mfma_f32_32x32x16_bf16(pa0, MLA_PK(l0, h0), od, 0, 0, 0);
  od = __builtin_amdgcn_mfma_f32_32x32x16_bf16(pa1, MLA_PK(l1, h1), od, 0, 0, 0);
  od = __builtin_amdgcn_mfma_f32_32x32x16_bf16(pa2, MLA_PK(l2, h2), od, 0, 0, 0);
  od = __builtin_amdgcn_mfma_f32_32x32x16_bf16(pa3, MLA_PK(l3, h3), od, 0, 0, 0);
#undef MLA_PK
}
__device__ __forceinline__ void pv_d0(f32x16 (&o)[4], int vb, bf16x8 pa0, bf16x8 pa1, bf16x8 pa2, bf16x8 pa3) {
  pv_one<0>(o[0], vb, pa0, pa1, pa2, pa3); pv_one<1>(o[1], vb, pa0, pa1, pa2, pa3); pv_one<2>(o[2], vb, pa0, pa1, pa2, pa3); pv_one<3>(o[3], vb, pa0, pa1, pa2, pa3);
}
__device__ __forceinline__ void attn_unit(int tid, const bf16_t* __restrict__ Qb, const bf16_t* __restrict__ Kh, const bf16_t* __restrict__ Vh, const bf16_t* __restrict__ Kp,
                                          bf16_t* __restrict__ Ob, float* __restrict__ ssq, LAS char* lds) {
  constexpr int LDQ = 1536, LDK = 1024, LDP = 64, LDO = 2048, NT = SEQ / KVBLK;
  const int wid = tid >> 6, lane = tid & 63, r32 = lane & 31, hi = lane >> 5;
  LAS char* V_lds = lds; LAS char* K_lds = lds + 3 * SHM_V;
  LAS float* wsf = (LAS float*)(lds + 3 * SHM_V + 2 * SHM_K) + wid * 64; LAS float* li_l = wsf; LAS float* al_l = wsf + 32;
  float m_reg = -1e30f, l_reg = 0; f32x16 o[4] = {}; bf16x8 qr[12];
  const bf16_t* Qw = Qb + (long)(wid * QBLK + r32) * LDQ + hi * 8;
#pragma unroll
  for (int d0 = 0; d0 < 12; ++d0) qr[d0] = *reinterpret_cast<const bf16x8*>(Qw + d0 * 16);
  const int sr = tid >> 4, sc = (tid & 15) * 8, vst0 = v_st(sr, sc), vst1 = v_st(32 + sr, sc);
  const int rr = tid >> 3, rc = (tid & 7) * 8;
  const int vb0 = (int)(uintptr_t)V_lds + v_rd_base(lane);
  bf16x8 s_vs0, s_vs1, s_ks0, s_ks1, s_kr;
#define MLA_SLOAD(k0) do { s_vs0 = *reinterpret_cast<const bf16x8*>(&Vh[(long)((k0) + sr) * LDK + sc]); s_vs1 = *reinterpret_cast<const bf16x8*>(&Vh[(long)((k0) + 32 + sr) * LDK + sc]); \
    s_ks0 = *reinterpret_cast<const bf16x8*>(&Kh[(long)((k0) + sr) * LDK + sc]); s_ks1 = *reinterpret_cast<const bf16x8*>(&Kh[(long)((k0) + 32 + sr) * LDK + sc]); \
    s_kr = *reinterpret_cast<const bf16x8*>(&Kp[(long)((k0) + rr) * LDP + rc]); } while (0)
#define MLA_SWRITE(kb, vbuf) do { *(LAS bf16x8*)(V_lds + (vbuf) * SHM_V + vst0) = s_vs0; *(LAS bf16x8*)(V_lds + (vbuf) * SHM_V + vst1) = s_vs1; const int kc = sc * 2; \
    *(LAS bf16x8*)(K_lds + (kb) * SHM_K + MLA_KSWZ(sr, kc)) = s_ks0; *(LAS bf16x8*)(K_lds + (kb) * SHM_K + MLA_KSWZ(32 + sr, kc)) = s_ks1; \
    *(LAS bf16x8*)(K_lds + (kb) * SHM_K + MLA_KSWZ(rr, 256 + rc * 2)) = s_kr; } while (0)
#define MLA_SWAIT() asm volatile("s_waitcnt vmcnt(0)" ::: "memory")
#define MLA_RESC(a) do { if (__any((a) < 1.f)) { if (hi == 0) al_l[r32] = (a); asm volatile("s_waitcnt lgkmcnt(0)" ::: "memory"); \
    _Pragma("unroll") for (int d = 0; d < 4; ++d) _Pragma("unroll") for (int r = 0; r < 16; ++r) o[d][r] *= al_l[crow(r, hi)]; } } while (0)
  f32x16 p0, p1; float mn, al; bf16x8 pa0, pa1, pa2, pa3;
  const bool grpB = wid >= 4;
  MLA_SLOAD(0); MLA_SWAIT(); MLA_SWRITE(0, 0); MLA_SLOAD(KVBLK); __syncthreads();
  int vcur = 0;
  for (int j = 0; j < NT; ++j) {
    const int kbuf = j & 1, vnext = vcur == 2 ? 0 : vcur + 1, vprev = vcur == 0 ? 2 : vcur - 1;
    if (j + 1 < NT) { MLA_SWAIT(); MLA_SWRITE(kbuf ^ 1, vnext); }
    if (j + 2 < NT) MLA_SLOAD((j + 2) * KVBLK);
    MLA_SBAR();
    if (!grpB) {
      qkt(p0, p1, K_lds + kbuf * SHM_K, qr, r32, hi);
      partialSM(p0, p1, m_reg, mn, al);
      MLA_RESC(al);
      finishSM(p0, p1, al, l_reg, pa0, pa1, pa2, pa3); MLA_SBAR();
      pv_d0(o, vb0 + vcur * SHM_V, pa0, pa1, pa2, pa3);
    } else {
      if (j > 0) pv_d0(o, vb0 + vprev * SHM_V, pa0, pa1, pa2, pa3);
      MLA_SBAR(); qkt(p0, p1, K_lds + kbuf * SHM_K, qr, r32, hi);
      partialSM(p0, p1, m_reg, mn, al);
      MLA_RESC(al);
      finishSM(p0, p1, al, l_reg, pa0, pa1, pa2, pa3);
    }
    __syncthreads();
    vcur = vnext;
  }
  if (grpB) pv_d0(o, vb0 + (vcur == 0 ? 2 : vcur - 1) * SHM_V, pa0, pa1, pa2, pa3);
  if (hi == 0) li_l[r32] = l_reg; asm volatile("s_waitcnt lgkmcnt(0)" ::: "memory");
  float rli[16];
#pragma unroll
  for (int r = 0; r < 16; ++r) rli[r] = __builtin_amdgcn_rcpf(li_l[crow(r, hi)]);
  bf16_t* Ow = Ob + (long)(wid * QBLK) * LDO;
  float ssr[16];
#pragma unroll
  for (int r = 0; r < 16; ++r) { const int orow = crow(r, hi); float sq = 0.f;
#pragma unroll
    for (int d0 = 0; d0 < 4; ++d0) { const unsigned bv = f2bf(o[d0][r] * rli[r]); Ow[(long)orow * LDO + d0 * 32 + r32] = (bf16_t)bv; const float fv = __uint_as_float(bv << 16); sq += fv * fv; }
    ssr[r] = sq; }
  half32_rowsum_store(ssr, lane, ssq + wid * QBLK * 8, 8);
#undef MLA_SLOAD
#undef MLA_SWRITE
#undef MLA_SWAIT
#undef MLA_RESC
}
}

namespace natm {
using mla::bf16x8; using mla::f32x16; using mla::crow;
constexpr int SHM_T = 64 * 128 * 2;
constexpr int OFF_V = 0, OFF_K = 2 * SHM_T, OFF_RP = 4 * SHM_T, OFF_WS = OFF_RP + 30720, LDS_NAT = OFF_WS + 8 * 256;
#define NAT_KSWZ(row, colB) ((row) * 256 + ((colB) ^ (((row) & 7) << 4)))
template <int HH> __device__ __forceinline__ void qkt(f32x16& p0, f32x16& p1, const LAS char* Ks, const bf16x8 (&qr)[2][4], int r32, int hi) {
  p0 = f32x16{}; p1 = f32x16{};
#pragma unroll
  for (int d0 = 0; d0 < 4; ++d0) { const int cb = (HH * 64 + d0 * 16 + hi * 8) * 2;
    const bf16x8 b0 = *reinterpret_cast<const LAS bf16x8*>(Ks + NAT_KSWZ(r32, cb));
    const bf16x8 b1 = *reinterpret_cast<const LAS bf16x8*>(Ks + NAT_KSWZ(32 + r32, cb));
    p0 = __builtin_amdgcn_mfma_f32_32x32x16_bf16(b0, qr[HH][d0], p0, 0, 0, 0);
    p1 = __builtin_amdgcn_mfma_f32_32x32x16_bf16(b1, qr[HH][d0], p1, 0, 0, 0); }
}
template <int PAR> __device__ __forceinline__ constexpr bool act0(int r) { return PAR == 0 || r >= 12; }
template <int PAR> __device__ __forceinline__ constexpr bool act1(int r) { return PAR == 1 || r < 4; }
template <int PAR> __device__ __forceinline__ void bias_mask(f32x16& p0, f32x16& p1, const LAS float* bp, int cs, int hi) {
#pragma unroll
  for (int r = 0; r < 16; ++r) { const int kc0 = (r & 3) + 8 * (r >> 2);
    const int kc = kc0 + 4 * hi;
    if (act0<PAR>(r)) p0[r] = ((unsigned)(kc - cs) < 16u) ? p0[r] + bp[kc] : -1e30f;
    if (act1<PAR>(r)) p1[r] = ((unsigned)(kc + 32 - cs) < 16u) ? p1[r] + bp[kc + 32] : -1e30f; }
}
template <int PAR> __device__ __forceinline__ void partialSM(f32x16& p0, f32x16& p1, float& m_reg, float& mn, float& alpha) {
  constexpr float C = 1.4426950408889634f;
  float pmax = -1e30f;
#pragma unroll
  for (int r = 0; r < 16; ++r) if (act0<PAR>(r)) pmax = fmaxf(pmax, p0[r]);
#pragma unroll
  for (int r = 0; r < 16; ++r) if (act1<PAR>(r)) pmax = fmaxf(pmax, p1[r]);
  { auto rr = __builtin_amdgcn_permlane32_swap(__float_as_uint(pmax), __float_as_uint(pmax), false, false);
    pmax = fmaxf(__uint_as_float(rr[0]), __uint_as_float(rr[1])); }
  if (__builtin_expect(__all(pmax - m_reg <= mla::THR), 1)) { mn = m_reg; alpha = 1.f; }
  else { mn = fmaxf(m_reg, pmax); alpha = __builtin_amdgcn_exp2f((m_reg - mn) * C); m_reg = mn; }
  const float mnC = -mn * C;
#pragma unroll
  for (int r = 0; r < 16; ++r) p0[r] = act0<PAR>(r) ? __builtin_amdgcn_exp2f(fmaf(p0[r], C, mnC)) : 0.f;
#pragma unroll
  for (int r = 0; r < 16; ++r) p1[r] = act1<PAR>(r) ? __builtin_amdgcn_exp2f(fmaf(p1[r], C, mnC)) : 0.f;
}
template <int PAR> __device__ __forceinline__ void finishSM(f32x16& p0, f32x16& p1, float alpha, float& l_reg, bf16x8& pa0, bf16x8& pa1, bf16x8& pa2, bf16x8& pa3) {
  float ps = 0;
#pragma unroll
  for (int r = 0; r < 16; ++r) if (act0<PAR>(r)) ps += p0[r];
#pragma unroll
  for (int r = 0; r < 16; ++r) if (act1<PAR>(r)) ps += p1[r];
  { auto rr = __builtin_amdgcn_permlane32_swap(__float_as_uint(ps), __float_as_uint(ps), false, false);
    ps = __uint_as_float(rr[0]) + __uint_as_float(rr[1]); }
  l_reg = l_reg * alpha + ps;
#define NAT_CV(P, A, i) ((A(i) || A(i + 1)) ? mla::cvtpk(P[i], P[i + 1]) : 0u)
#define NAT_PK4(P, A, BASE, OUT) do { const unsigned a0 = NAT_CV(P, A, BASE + 0), a1 = NAT_CV(P, A, BASE + 2), b0 = NAT_CV(P, A, BASE + 4), b1 = NAT_CV(P, A, BASE + 6); \
    if (A(BASE) || A(BASE + 7)) { auto r0 = __builtin_amdgcn_permlane32_swap(a0, b0, false, false); auto r1 = __builtin_amdgcn_permlane32_swap(a1, b1, false, false); \
      mla::u32x4v w = {r0[0], r1[0], r0[1], r1[1]}; OUT = *reinterpret_cast<bf16x8*>(&w); } else { OUT = bf16x8{0, 0, 0, 0, 0, 0, 0, 0}; } } while (0)
  NAT_PK4(p0, act0<PAR>, 0, pa0); NAT_PK4(p0, act0<PAR>, 8, pa1); NAT_PK4(p1, act1<PAR>, 0, pa2); NAT_PK4(p1, act1<PAR>, 8, pa3);
#undef NAT_PK4
#undef NAT_CV
}
template <int HH, int PAR> __device__ __forceinline__ void head_step(f32x16 (&o)[2][2], float (&m_reg)[2], float (&l_reg)[2], const LAS char* Kt, int vb, const bf16x8 (&qr)[2][4],
                                                            const LAS float* bp, int cs, int r32, int hi, LAS float* al_l) {
  f32x16 p0, p1; float mn, al; bf16x8 pa0, pa1, pa2, pa3;
  qkt<HH>(p0, p1, Kt, qr, r32, hi);
  bias_mask<PAR>(p0, p1, bp, cs, hi);
  partialSM<PAR>(p0, p1, m_reg[HH], mn, al);
  if (__any(al < 1.f)) { if (hi == 0) al_l[r32] = al; asm volatile("s_waitcnt lgkmcnt(0)" ::: "memory");
#pragma unroll
    for (int d = 0; d < 2; ++d)
#pragma unroll
      for (int r = 0; r < 16; ++r) o[HH][d][r] *= al_l[crow(r, hi)]; }
  finishSM<PAR>(p0, p1, al, l_reg[HH], pa0, pa1, pa2, pa3); __builtin_amdgcn_sched_barrier(0);
  mla::pv_one<2 * HH>(o[HH][0], vb, pa0, pa1, pa2, pa3); mla::pv_one<2 * HH + 1>(o[HH][1], vb, pa0, pa1, pa2, pa3);
}
__device__ __forceinline__ void nat_unit(int unit, int tid, const bf16_t* __restrict__ nq, const bf16_t* __restrict__ nk, const bf16_t* __restrict__ nv, bf16_t* __restrict__ out, float* __restrict__ ssq, LAS char* lds) {
  const int rg = unit & 7, hp = (unit >> 3) & 7, b = unit >> 6;
  const int wid = tid >> 6, lane = tid & 63, r32 = lane & 31, hi = lane >> 5;
  const int rw = 4 * rg + (wid >> 1), c = 32 * (wid & 1) + r32, cs = min(max(c - 8, 0), 48), rsw = min(max(rw - 4, 0), 24);
  const int kfirst = min(max(4 * rg - 4, 0), 24), klast = min(max(4 * rg + 3 - 4, 0), 24) + 7;
  LAS char* V_lds = lds + OFF_V; LAS char* K_lds = lds + OFF_K; const LAS float* rp = (const LAS float*)(lds + OFF_RP);
  LAS float* wsf = (LAS float*)(lds + OFF_WS) + wid * 64; LAS float* li_l = wsf; LAS float* al_l = wsf + 32;
  const size_t tb = (size_t)b * 2048;
  bf16x8 qr[2][4];
  { const bf16_t* Qw = nq + (tb + rw * 64 + c) * 1024 + hp * 128 + hi * 8;
#pragma unroll
    for (int hh = 0; hh < 2; ++hh)
#pragma unroll
      for (int d0 = 0; d0 < 4; ++d0) qr[hh][d0] = *reinterpret_cast<const bf16x8*>(Qw + hh * 64 + d0 * 16); }
  float m_reg[2] = {-1e30f, -1e30f}, l_reg[2] = {0.f, 0.f}; f32x16 o[2][2] = {};
  const int sr = tid >> 4, sc = (tid & 15) * 8, vst0 = mla::v_st(sr, sc), vst1 = mla::v_st(32 + sr, sc);
  const int vb0 = (int)(uintptr_t)V_lds + mla::v_rd_base(lane);
  const bf16_t* Kh = nk + tb * 1024 + hp * 128; const bf16_t* Vh = nv + tb * 1024 + hp * 128;
  bf16x8 s_vs0, s_vs1, s_ks0, s_ks1;
#define NATM_SLOAD(kr) do { const long k0_ = (long)(kr) * 64; s_vs0 = *reinterpret_cast<const bf16x8*>(&Vh[(k0_ + sr) * 1024 + sc]); s_vs1 = *reinterpret_cast<const bf16x8*>(&Vh[(k0_ + 32 + sr) * 1024 + sc]); \
    s_ks0 = *reinterpret_cast<const bf16x8*>(&Kh[(k0_ + sr) * 1024 + sc]); s_ks1 = *reinterpret_cast<const bf16x8*>(&Kh[(k0_ + 32 + sr) * 1024 + sc]); } while (0)
#define NATM_SWRITE(bf) do { *(LAS bf16x8*)(V_lds + (bf) * SHM_T + vst0) = s_vs0; *(LAS bf16x8*)(V_lds + (bf) * SHM_T + vst1) = s_vs1; const int kc_ = sc * 2; \
    *(LAS bf16x8*)(K_lds + (bf) * SHM_T + NAT_KSWZ(sr, kc_)) = s_ks0; *(LAS bf16x8*)(K_lds + (bf) * SHM_T + NAT_KSWZ(32 + sr, kc_)) = s_ks1; } while (0)
  NATM_SLOAD(kfirst); asm volatile("s_waitcnt vmcnt(0)" ::: "memory"); NATM_SWRITE(0);
  if (kfirst < klast) NATM_SLOAD(kfirst + 1);
  __syncthreads();
  for (int kr = kfirst; kr <= klast; ++kr) {
    const int buf = (kr - kfirst) & 1;
    if (kr < klast) { asm volatile("s_waitcnt vmcnt(0)" ::: "memory"); NATM_SWRITE(buf ^ 1); }
    if (kr + 1 < klast) NATM_SLOAD(kr + 2);
    __builtin_amdgcn_sched_barrier(0);
    if (kr >= rsw && kr < rsw + 8) {
      const LAS float* bp0 = rp + (2 * hp) * 465 + (kr - rw + 7) * 31 + (15 - c);
      if (wid & 1) { head_step<0, 1>(o, m_reg, l_reg, K_lds + buf * SHM_T, vb0 + buf * SHM_T, qr, bp0, cs, r32, hi, al_l);
                     head_step<1, 1>(o, m_reg, l_reg, K_lds + buf * SHM_T, vb0 + buf * SHM_T, qr, bp0 + 465, cs, r32, hi, al_l); }
      else         { head_step<0, 0>(o, m_reg, l_reg, K_lds + buf * SHM_T, vb0 + buf * SHM_T, qr, bp0, cs, r32, hi, al_l);
                     head_step<1, 0>(o, m_reg, l_reg, K_lds + buf * SHM_T, vb0 + buf * SHM_T, qr, bp0 + 465, cs, r32, hi, al_l); }
    }
    __syncthreads();
  }
#undef NATM_SLOAD
#undef NATM_SWRITE
  float ssr[16];
#pragma unroll
  for (int r = 0; r < 16; ++r) ssr[r] = 0.f;
#pragma unroll
  for (int hh = 0; hh < 2; ++hh) {
    if (hi == 0) li_l[r32] = l_reg[hh]; asm volatile("s_waitcnt lgkmcnt(0)" ::: "memory");
    float rli[16];
#pragma unroll
    for (int r = 0; r < 16; ++r) rli[r] = __builtin_amdgcn_rcpf(li_l[crow(r, hi)]);
    asm volatile("s_waitcnt lgkmcnt(0)" ::: "memory");
    bf16_t* Ow = out + (tb + rw * 64 + 32 * (wid & 1)) * 2048 + hp * 128 + hh * 64;
#pragma unroll
    for (int r = 0; r < 16; ++r) { const int orow = crow(r, hi);
#pragma unroll
      for (int db = 0; db < 2; ++db) { const unsigned bv = f2bf(o[hh][db][r] * rli[r]); Ow[(long)orow * 2048 + db * 32 + r32] = (bf16_t)bv; const float fv = __uint_as_float(bv << 16); ssr[r] += fv * fv; } }
  }
  mla::half32_rowsum_store(ssr, lane, ssq + (tb + rw * 64 + 32 * (wid & 1)) * 8 + hp, 8);
}
}

constexpr size_t MiB = 1u << 20;
constexpr size_t WS_CTL = 0, WS_WIN = 4 * MiB, WS_WUQ = WS_WIN + 64 * MiB, WS_WUKV = WS_WUQ + 6 * MiB, WS_WOUT = WS_WUKV + 4 * MiB, WS_WPQ = WS_WOUT + 32 * MiB,
                 WS_U = WS_WPQ + 32 * MiB, WS_V = WS_U + 128 * MiB, WS_US = WS_V + 128 * MiB, WS_VS = WS_US + 1 * MiB, WS_RSS = WS_VS + 1 * MiB, WS_MSS = WS_RSS + 256 * 1024  , WS_KT = WS_RSS + 1 * MiB, WS_ROPE = WS_KT + 1 * MiB, WS_X32 = WS_ROPE + 1 * MiB,
                 WS_H = WS_X32 + 128 * MiB, WS_CQ = WS_H + 64 * MiB, WS_CKV = WS_CQ + 16 * MiB, WS_KPE = WS_CKV + 8 * MiB, WS_NQ = WS_KPE + 2 * MiB,
                 WS_NK = WS_NQ + 32 * MiB, WS_NV = WS_NK + 32 * MiB, WS_CQN = WS_NV + 32 * MiB, WS_CKVN = WS_CQN + 16 * MiB, WS_Q = WS_CKVN + 8 * MiB,
                 WS_KN = WS_Q + 48 * MiB, WS_VV = WS_KN + 32 * MiB, WS_MIX = WS_VV + 32 * MiB, WS_PQ = WS_MIX + 64 * MiB, WS_MP = WS_PQ + 64 * MiB  , WS_NP = WS_MP + 1 * MiB  ,
                 WS_XP = WS_NP + 1 * MiB  , WS_LP = WS_XP + 2 * MiB  , WS_END = WS_LP + 1 * MiB;
constexpr int LDS_BYTES = 155648, LDS_BAR_OFF = 153600;
#define LDS_WAIT() asm volatile("s_waitcnt lgkmcnt(0)" ::: "memory")

struct MkArgs { const float* in[17]; float* out; unsigned char* ws; };

__device__ __forceinline__ void transpose_item(const float* __restrict__ W, int K, int N, int NP, int mode, bf16_t* __restrict__ WT, LAS float* scr, int item, int lane, const float* __restrict__ kgain) {
    const int nblk = NP / 32, kb = item / nblk, nb = item % nblk, k0 = 64 * kb, n0 = 32 * nb;
    const int kk0 = lane >> 3, nq = (lane & 7) * 4;
    const int s0 = src_col(mode, n0 + nq), s1 = src_col(mode, n0 + nq + 1), s2 = src_col(mode, n0 + nq + 2), s3 = src_col(mode, n0 + nq + 3);
    const bool contig = (s0 >= 0) && (s1 == s0 + 1) && (s2 == s0 + 2) && (s3 == s0 + 3) && ((s0 & 3) == 0) && ((N & 3) == 0);
#pragma unroll
    for (int i = 0; i < 8; ++i) { const int kk = 8 * i + kk0; const float* wr = W + (size_t)(k0 + kk) * N; f32x4 v;
        if (contig) v = *(const f32x4*)(wr + s0);
        else { v.x = s0 >= 0 ? wr[s0] : 0.f; v.y = s1 >= 0 ? wr[s1] : 0.f; v.z = s2 >= 0 ? wr[s2] : 0.f; v.w = s3 >= 0 ? wr[s3] : 0.f; }
        if (kgain) { const float g = kgain[k0 + kk]; v = v * g; }
        LAS float* d = scr + kk * 33 + nq; d[0] = v.x; d[1] = v.y; d[2] = v.z; d[3] = v.w; }
    LDS_WAIT();
    const int c = lane & 7;
#pragma unroll
    for (int j = 0; j < 4; ++j) { const int n = (lane >> 3) + 8 * j; const LAS float* s = scr + (8 * c) * 33 + n;
        u32x4 o; o.x = pk2(s[0 * 33], s[1 * 33]); o.y = pk2(s[2 * 33], s[3 * 33]); o.z = pk2(s[4 * 33], s[5 * 33]); o.w = pk2(s[6 * 33], s[7 * 33]);
        *(u32x4*)(WT + (size_t)(n0 + n) * K + k0 + 8 * c) = o; }
    LDS_WAIT();
}
__device__ __forceinline__ void conv_w_all(const float* __restrict__ W, bf16_t* __restrict__ WT, int K, int N, int NP, int mode, LAS float* scr, int gw, int NGW, int lane, const float* __restrict__ kgain = nullptr, const float* __restrict__ kgain2 = nullptr) {
    const int per = (K / 64) * (NP / 32);
    for (int it = gw; it < NL * per; it += NGW) { const int l = it / per, r = it % per; const int k0 = 64 * (r / (NP / 32));
        const float* kg = !kgain ? nullptr : !kgain2 ? kgain + (size_t)l * K : (k0 < K / 2 ? kgain + (size_t)l * (K / 2) : kgain2 + (size_t)l * (K / 2) - K / 2);
        transpose_item(W + (size_t)l * K * N, K, N, NP, mode, WT + (size_t)l * NP * K, scr, r, lane, kg); }
}
__device__ __forceinline__ void conv_bf16_all(const float* __restrict__ in, bf16_t* __restrict__ out, size_t n8, size_t gt, size_t NGT) {
    for (size_t i = gt; i < n8; i += NGT) {
        const f32x4 a = ((const f32x4*)in)[2 * i], b = ((const f32x4*)in)[2 * i + 1];
        u32x4 o; o.x = pk2(a.x, a.y); o.y = pk2(a.z, a.w); o.z = pk2(b.x, b.y); o.w = pk2(b.z, b.w);
        ((u32x4*)out)[i] = o; }
}
__device__ const double ROPE_REV[32] = {0.15915494309189535, 0.11934937021124886, 0.08949940160889101, 0.06711508300522726, 0.050329212104487035, 0.03774158471741977, 0.0283021958306234, 0.02122365276477766, 0.015915494309189534, 0.011934937021124886, 0.008949940160889102, 0.006711508300522725, 0.005032921210448704, 0.003774158471741977, 0.00283021958306234, 0.0021223652764777662, 0.0015915494309189536, 0.0011934937021124885, 0.0008949940160889102, 0.0006711508300522726, 0.0005032921210448703, 0.00037741584717419774, 0.00028302195830623395, 0.0002122365276477766, 0.00015915494309189535, 0.00011934937021124886, 8.949940160889102e-05, 6.711508300522725e-05, 5.0329212104487035e-05, 3.774158471741978e-05, 2.8302195830623396e-05, 2.122365276477766e-05};

__device__ __forceinline__ void norm_x_row(const float* __restrict__ xr, const float* __restrict__ gain, bf16_t* __restrict__ hr, bf16_t* __restrict__ xc, int lane) {
    f32x4 v[8]; float ss = 0.f;
#pragma unroll
    for (int j = 0; j < 4; ++j) { v[2 * j] = *(const f32x4*)(xr + j * 512 + lane * 8); v[2 * j + 1] = *(const f32x4*)(xr + j * 512 + lane * 8 + 4); }
#pragma unroll
    for (int j = 0; j < 8; ++j) ss += v[j].x * v[j].x + v[j].y * v[j].y + v[j].z * v[j].z + v[j].w * v[j].w;
    const float r = 1.0f / sqrtf(wave_sum(ss) * (1.0f / D) + EPS);
#pragma unroll
    for (int j = 0; j < 4; ++j) {
        const f32x4 g0 = *(const f32x4*)(gain + j * 512 + lane * 8), g1 = *(const f32x4*)(gain + j * 512 + lane * 8 + 4);
        const f32x4 a = v[2 * j], b = v[2 * j + 1];
        u32x4 o; o.x = pk2(a.x * r * g0.x, a.y * r * g0.y); o.y = pk2(a.z * r * g0.z, a.w * r * g0.w); o.z = pk2(b.x * r * g1.x, b.y * r * g1.y); o.w = pk2(b.z * r * g1.z, b.w * r * g1.w);
        *(u32x4*)(hr + j * 512 + lane * 8) = o;
        if (xc) { u32x4 q; q.x = pk2(a.x, a.y); q.y = pk2(a.z, a.w); q.z = pk2(b.x, b.y); q.w = pk2(b.z, b.w); *(u32x4*)(xc + j * 512 + lane * 8) = q; }
    }
}
__device__ __forceinline__ void lat_norm_row(int t, int lane, const bf16_t* __restrict__ cq, const bf16_t* __restrict__ ckv, const float* __restrict__ gq, const float* __restrict__ gkv, bf16_t* __restrict__ cqn, bf16_t* __restrict__ ckvn) {
    { const u32x4 a = *(const u32x4*)(cq + (size_t)t * 512 + lane * 8);
      float f[8] = {bflo(a.x), bfhi(a.x), bflo(a.y), bfhi(a.y), bflo(a.z), bfhi(a.z), bflo(a.w), bfhi(a.w)};
      float ss = 0.f;
#pragma unroll
      for (int i = 0; i < 8; ++i) ss += f[i] * f[i];
      const float r = 1.0f / sqrtf(wave_sum(ss) * (1.0f / 512) + EPS);
      const f32x4 g0 = *(const f32x4*)(gq + lane * 8), g1 = *(const f32x4*)(gq + lane * 8 + 4);
      u32x4 o; o.x = pk2(f[0] * r * g0.x, f[1] * r * g0.y); o.y = pk2(f[2] * r * g0.z, f[3] * r * g0.w); o.z = pk2(f[4] * r * g1.x, f[5] * r * g1.y); o.w = pk2(f[6] * r * g1.z, f[7] * r * g1.w);
      *(u32x4*)(cqn + (size_t)t * 512 + lane * 8) = o; }
    { const u32x2 a = *(const u32x2*)(ckv + (size_t)t * 256 + lane * 4);
      float f[4] = {bflo(a.x), bfhi(a.x), bflo(a.y), bfhi(a.y)};
      const float ss = f[0] * f[0] + f[1] * f[1] + f[2] * f[2] + f[3] * f[3];
      const float r = 1.0f / sqrtf(wave_sum(ss) * (1.0f / 256) + EPS);
      const f32x4 g = *(const f32x4*)(gkv + lane * 4);
      u32x2 o; o.x = pk2(f[0] * r * g.x, f[1] * r * g.y); o.y = pk2(f[2] * r * g.z, f[3] * r * g.w);
      *(u32x2*)(ckvn + (size_t)t * 256 + lane * 4) = o; }
}
__device__ __forceinline__ void unpack16(const bf16_t* p, float (&f)[16]) {
    const u32x4 a = *(const u32x4*)p, b = *(const u32x4*)(p + 8);
    f[0] = bflo(a.x); f[1] = bfhi(a.x); f[2] = bflo(a.y); f[3] = bfhi(a.y); f[4] = bflo(a.z); f[5] = bfhi(a.z); f[6] = bflo(a.w); f[7] = bfhi(a.w);
    f[8] = bflo(b.x); f[9] = bfhi(b.x); f[10] = bflo(b.y); f[11] = bfhi(b.y); f[12] = bflo(b.z); f[13] = bfhi(b.z); f[14] = bflo(b.w); f[15] = bfhi(b.w);
}
__device__ __forceinline__ void norm16_store(float (&o)[16], float rr, const float* __restrict__ g, bf16_t* __restrict__ dst) {
    float gg[16];
#pragma unroll
    for (int i = 0; i < 4; ++i) { const f32x4 q = *(const f32x4*)(g + 4 * i); gg[4 * i] = q.x; gg[4 * i + 1] = q.y; gg[4 * i + 2] = q.z; gg[4 * i + 3] = q.w; }
    u32x4 o0, o1;
    o0.x = pk2(o[0] * rr * gg[0], o[1] * rr * gg[1]); o0.y = pk2(o[2] * rr * gg[2], o[3] * rr * gg[3]); o0.z = pk2(o[4] * rr * gg[4], o[5] * rr * gg[5]); o0.w = pk2(o[6] * rr * gg[6], o[7] * rr * gg[7]);
    o1.x = pk2(o[8] * rr * gg[8], o[9] * rr * gg[9]); o1.y = pk2(o[10] * rr * gg[10], o[11] * rr * gg[11]); o1.z = pk2(o[12] * rr * gg[12], o[13] * rr * gg[13]); o1.w = pk2(o[14] * rr * gg[14], o[15] * rr * gg[15]);
    *(u32x4*)dst = o0; *(u32x4*)(dst + 8) = o1;
}
__device__ __forceinline__ void mla_norm_row(int t, int lane, bf16_t* __restrict__ mix, const float* __restrict__ g) {
    bf16_t* p = mix + (size_t)t * 2048 + lane * 16;
    float f[16]; unpack16(p, f);
    float ss = 0.f;
#pragma unroll
    for (int i = 0; i < 16; ++i) ss += f[i] * f[i];
    const float r = 1.0f / sqrtf(wave_sum(ss) * (1.0f / 1024) + EPS);
    norm16_store(f, r, g + lane * 16, p);
}
__device__ __forceinline__ float dpp_quad_sum(float s) {
    s += __int_as_float(__builtin_amdgcn_mov_dpp(__float_as_int(s), 0xB1, 0xF, 0xF, true));
    s += __int_as_float(__builtin_amdgcn_mov_dpp(__float_as_int(s), 0x4E, 0xF, 0xF, true));
    return s;
}
typedef __bf16 cvtpk_bf16_b2 __attribute__((ext_vector_type(2))); typedef float cvtpk_bf16_f2 __attribute__((ext_vector_type(2)));
__device__ __forceinline__ unsigned cvtpk_bf16(float lo, float hi) { const cvtpk_bf16_f2 v = {lo, hi}; return __builtin_bit_cast(unsigned, __builtin_convertvector(v, cvtpk_bf16_b2)); }
#define NAT_PV2(wa, wb, ep, j) do { const unsigned lo_ = __builtin_amdgcn_perm((wb), (wa), 0x05040100u), hi_ = __builtin_amdgcn_perm((wb), (wa), 0x07060302u); \
    o[2 * (j)] = dot2(lo_, (ep), o[2 * (j)]); o[2 * (j) + 1] = dot2(hi_, (ep), o[2 * (j) + 1]); } while (0)
__device__ __forceinline__ void nat_token(int t, int lane, const LAS float* rp, const bf16_t* __restrict__ nq, const bf16_t* __restrict__ nk, const bf16_t* __restrict__ nv, const float* __restrict__ gain, bf16_t* __restrict__ mix) {
    const int b = t >> 11, s = t & 2047, r = s >> 6, c = s & 63;
    const int rs = min(max(r - 4, 0), 24), cs = min(max(c - 8, 0), 48), hd = lane >> 2;
    const u32x4 qa = *(const u32x4*)(nq + (size_t)t * 1024 + lane * 16), qb = *(const u32x4*)(nq + (size_t)t * 1024 + lane * 16 + 8);
    const LAS float* rph = rp + hd * 465 + (rs - r + 7) * 31 + (cs - c + 15);
    const size_t kb = ((size_t)b * 2048 + rs * 64 + cs) * 1024 + lane * 16;
    float m = -1e30f, l = 0.f, o[16];
#pragma unroll
    for (int i = 0; i < 16; ++i) o[i] = 0.f;
    u32x4 K0[4][2], V0[4][2], K1[4][2], V1[4][2];
#define NAT_LOAD(KK, VV, cc) do { const size_t off_ = kb + (size_t)((((cc) >> 2) * 64 + ((cc) & 3) * 4) * 1024); _Pragma("unroll") for (int i_ = 0; i_ < 4; ++i_) { \
        KK[i_][0] = *(const u32x4*)(nk + off_ + i_ * 1024); KK[i_][1] = *(const u32x4*)(nk + off_ + i_ * 1024 + 8); VV[i_][0] = *(const u32x4*)(nv + off_ + i_ * 1024); VV[i_][1] = *(const u32x4*)(nv + off_ + i_ * 1024 + 8); } } while (0)
#define NAT_COMP(KK, VV, cc) do { float s_[4]; const LAS float* bp_ = rph + ((cc) >> 2) * 31 + ((cc) & 3) * 4; \
        _Pragma("unroll") for (int i_ = 0; i_ < 4; ++i_) { float a_ = 0.f; \
            a_ = dot2(KK[i_][0].x, qa.x, a_); a_ = dot2(KK[i_][0].y, qa.y, a_); a_ = dot2(KK[i_][0].z, qa.z, a_); a_ = dot2(KK[i_][0].w, qa.w, a_); \
            a_ = dot2(KK[i_][1].x, qb.x, a_); a_ = dot2(KK[i_][1].y, qb.y, a_); a_ = dot2(KK[i_][1].z, qb.z, a_); a_ = dot2(KK[i_][1].w, qb.w, a_); \
            s_[i_] = dpp_quad_sum(a_) + bp_[i_]; } \
        const float mn_ = fmaxf(fmaxf(m, fmaxf(s_[0], s_[1])), fmaxf(s_[2], s_[3])), al_ = __expf(m - mn_); \
        const float e0_ = __expf(s_[0] - mn_), e1_ = __expf(s_[1] - mn_), e2_ = __expf(s_[2] - mn_), e3_ = __expf(s_[3] - mn_); \
        l = l * al_ + ((e0_ + e1_) + (e2_ + e3_)); m = mn_; \
        _Pragma("unroll") for (int i_ = 0; i_ < 16; ++i_) o[i_] *= al_; \
        const unsigned p01_ = cvtpk_bf16(e0_, e1_), p23_ = cvtpk_bf16(e2_, e3_); \
        NAT_PV2(VV[0][0].x, VV[1][0].x, p01_, 0); NAT_PV2(VV[0][0].y, VV[1][0].y, p01_, 1); NAT_PV2(VV[0][0].z, VV[1][0].z, p01_, 2); NAT_PV2(VV[0][0].w, VV[1][0].w, p01_, 3); \
        NAT_PV2(VV[0][1].x, VV[1][1].x, p01_, 4); NAT_PV2(VV[0][1].y, VV[1][1].y, p01_, 5); NAT_PV2(VV[0][1].z, VV[1][1].z, p01_, 6); NAT_PV2(VV[0][1].w, VV[1][1].w, p01_, 7); \
        NAT_PV2(VV[2][0].x, VV[3][0].x, p23_, 0); NAT_PV2(VV[2][0].y, VV[3][0].y, p23_, 1); NAT_PV2(VV[2][0].z, VV[3][0].z, p23_, 2); NAT_PV2(VV[2][0].w, VV[3][0].w, p23_, 3); \
        NAT_PV2(VV[2][1].x, VV[3][1].x, p23_, 4); NAT_PV2(VV[2][1].y, VV[3][1].y, p23_, 5); NAT_PV2(VV[2][1].z, VV[3][1].z, p23_, 6); NAT_PV2(VV[2][1].w, VV[3][1].w, p23_, 7); } while (0)
    NAT_LOAD(K0, V0, 0);
    for (int cc = 0; cc < 32; cc += 2) {
        NAT_LOAD(K1, V1, cc + 1);
        NAT_COMP(K0, V0, cc);
        if (cc + 2 < 32) NAT_LOAD(K0, V0, cc + 2);
        NAT_COMP(K1, V1, cc + 1);
    }
#undef NAT_LOAD
#undef NAT_COMP
    const float il = 1.0f / l; float ss = 0.f;
#pragma unroll
    for (int i = 0; i < 16; ++i) { o[i] *= il; ss += o[i] * o[i]; }
    const float rr = 1.0f / sqrtf(wave_sum(ss) * (1.0f / 1024) + EPS);
    norm16_store(o, rr, gain + lane * 16, mix + (size_t)t * 2048 + 1024 + lane * 16);
}

__device__ __forceinline__ void st8f(LAS float* d, u32x4 v) { d[0] = bflo(v.x); d[1] = bfhi(v.x); d[2] = bflo(v.y); d[3] = bfhi(v.y); d[4] = bflo(v.z); d[5] = bfhi(v.z); d[6] = bflo(v.w); d[7] = bfhi(v.w); }
__device__ __forceinline__ void mla_unit(int unit, int tid, LAS unsigned char* lds, const bf16_t* __restrict__ Q, const bf16_t* __restrict__ Kn, const bf16_t* __restrict__ Vv, const bf16_t* __restrict__ kpe, bf16_t* __restrict__ mix) {
    LAS float* Qs = (LAS float*)lds; LAS float* Ks = Qs + 64 * 196; LAS float* Vs = Ks + 64 * 196; LAS float* Pt = Vs + 64 * 128;
    const int lane = tid & 63, w = tid >> 6;
    const int qb = unit & 31, hd = (unit >> 5) & 7, b = unit >> 8;
    const size_t t0 = (size_t)b * 2048 + qb * 64;
    __syncthreads();
    for (int i = tid; i < 64 * 24; i += 512) { const int r = i / 24, ch = i % 24; st8f(Qs + r * 196 + ch * 8, *(const u32x4*)(Q + (t0 + r) * 1536 + hd * 192 + ch * 8)); }
    float m[8], l[8], o0[8], o1[8];
#pragma unroll
    for (int i = 0; i < 8; ++i) { m[i] = -INFINITY; l[i] = 0.f; o0[i] = 0.f; o1[i] = 0.f; }
    LAS float* P = Pt + w * 512;
    for (int kt = 0; kt < 32; ++kt) {
        __syncthreads();
        const size_t k0 = (size_t)b * 2048 + kt * 64;
        for (int i = tid; i < 64 * 24; i += 512) { const int r = i / 24, ch = i % 24;
            const bf16_t* src = ch < 16 ? Kn + (k0 + r) * 1024 + hd * 128 + ch * 8 : kpe + (k0 + r) * 64 + (ch - 16) * 8;
            st8f(Ks + r * 196 + ch * 8, *(const u32x4*)src); }
        for (int i = tid; i < 64 * 16; i += 512) { const int r = i / 16, ch = i % 16; st8f(Vs + r * 128 + ch * 8, *(const u32x4*)(Vv + (k0 + r) * 1024 + hd * 128 + ch * 8)); }
        __syncthreads();
#pragma unroll
        for (int qi = 0; qi < 8; ++qi) {
            const LAS f32x4* qp = (const LAS f32x4*)(Qs + (w * 8 + qi) * 196); const LAS f32x4* kp = (const LAS f32x4*)(Ks + lane * 196);
            float s = 0.f;
#pragma unroll 8
            for (int d = 0; d < 48; ++d) { const f32x4 a = qp[d], k = kp[d]; s += a.x * k.x + a.y * k.y + a.z * k.z + a.w * k.w; }
            const float mx = wave_max(s), mn = fmaxf(m[qi], mx), alpha = __expf(m[qi] - mn), p = __expf(s - mn), ps = wave_sum(p);
            l[qi] = l[qi] * alpha + ps; m[qi] = mn; o0[qi] *= alpha; o1[qi] *= alpha;
            P[lane * 8 + qi] = p;
        }
        for (int key = 0; key < 64; ++key) {
            const f32x4 pa = *(const LAS f32x4*)(P + key * 8), pb = *(const LAS f32x4*)(P + key * 8 + 4);
            const float v0 = Vs[key * 128 + lane], v1 = Vs[key * 128 + 64 + lane];
            o0[0] += pa.x * v0; o1[0] += pa.x * v1; o0[1] += pa.y * v0; o1[1] += pa.y * v1; o0[2] += pa.z * v0; o1[2] += pa.z * v1; o0[3] += pa.w * v0; o1[3] += pa.w * v1;
            o0[4] += pb.x * v0; o1[4] += pb.x * v1; o0[5] += pb.y * v0; o1[5] += pb.y * v1; o0[6] += pb.z * v0; o1[6] += pb.z * v1; o0[7] += pb.w * v0; o1[7] += pb.w * v1;
        }
    }
#pragma unroll
    for (int qi = 0; qi < 8; ++qi) { const float il = 1.0f / l[qi]; bf16_t* dst = mix + (t0 + w * 8 + qi) * 2048 + hd * 128;
        dst[lane] = (bf16_t)f2bf(o0[qi] * il); dst[64 + lane] = (bf16_t)f2bf(o1[qi] * il); }
}

typedef short rt_bf16x8 __attribute__((ext_vector_type(8)));
template <int C> __device__ __forceinline__ int dppi(int v) { return __builtin_amdgcn_mov_dpp(v, C, 0xF, 0xF, true); }
template <int C> __device__ __forceinline__ float dppf(float v) { return __int_as_float(__builtin_amdgcn_mov_dpp(__float_as_int(v), C, 0xF, 0xF, true)); }
__device__ __forceinline__ int row16_sum(int v) { v += dppi<0xB1>(v); v += dppi<0x4E>(v); v += dppi<0x141>(v); v += dppi<0x140>(v); return v; }
__device__ __forceinline__ int grp8_sum(int v) { v += dppi<0xB1>(v); v += dppi<0x4E>(v); v += dppi<0x141>(v); return v; }
__device__ __forceinline__ float row16_sumf(float v) { v += dppf<0xB1>(v); v += dppf<0x4E>(v); v += dppf<0x141>(v); v += dppf<0x140>(v); return v; }
__device__ __forceinline__ float row16_maxf(float v) { v = fmaxf(v, dppf<0xB1>(v)); v = fmaxf(v, dppf<0x4E>(v)); v = fmaxf(v, dppf<0x141>(v)); v = fmaxf(v, dppf<0x140>(v)); return v; }
__device__ __forceinline__ unsigned umaxu(unsigned a, unsigned b) { return a > b ? a : b; }
__device__ __forceinline__ unsigned row16_maxu(unsigned v) { v = umaxu(v, (unsigned)dppi<0xB1>((int)v)); v = umaxu(v, (unsigned)dppi<0x4E>((int)v)); v = umaxu(v, (unsigned)dppi<0x141>((int)v)); v = umaxu(v, (unsigned)dppi<0x140>((int)v)); return v; }
__device__ __forceinline__ unsigned grp8_maxu(unsigned v) { v = umaxu(v, (unsigned)dppi<0xB1>((int)v)); v = umaxu(v, (unsigned)dppi<0x4E>((int)v)); v = umaxu(v, (unsigned)dppi<0x141>((int)v)); return v; }
__device__ __forceinline__ int row16_incl_scan(int v) { v += dppi<0x111>(v); v += dppi<0x112>(v); v += dppi<0x114>(v); v += dppi<0x118>(v); return v; }
__device__ __forceinline__ int grp8_incl_scan(int v, int lane) { int t = dppi<0x111>(v); if ((lane & 7) >= 1) v += t; t = dppi<0x112>(v); if ((lane & 7) >= 2) v += t; t = dppi<0x114>(v); if ((lane & 7) >= 4) v += t; return v; }
__device__ __forceinline__ unsigned fkey(float f) { const unsigned u = __float_as_uint(f); return u ^ ((unsigned)((int)u >> 31) | 0x80000000u); }
__device__ __forceinline__ float funkey(unsigned k) { return __uint_as_float((k & 0x80000000u) ? (k ^ 0x80000000u) : ~k); }
__device__ __forceinline__ void peer_load_q(int t, int lane, const bf16_t* __restrict__ pq, rt_bf16x8 (&aq)[4]) {
    const int col = lane & 15, quad = lane >> 4; const bf16_t* qp = pq + (size_t)t * 2048 + (col & 7) * 256 + (col >> 3) * 128 + quad * 8;
#pragma unroll
    for (int ks = 0; ks < 4; ++ks) aq[ks] = *(const rt_bf16x8*)(qp + ks * 32);
}
__device__ __forceinline__ void peer_route(int lane, const LAS unsigned char* keys, LAS float* Lv, LAS int* Ln, LAS int* idxs, LAS float* gs, const rt_bf16x8 (&aqv)[4]) {
    const int col = lane & 15, quad = lane >> 4;
    unsigned uk[8][4];
    {
        rt_bf16x8 a1[4], a2[4]; const rt_bf16x8 zero = {0, 0, 0, 0, 0, 0, 0, 0};
#pragma unroll
        for (int ks = 0; ks < 4; ++ks) { const rt_bf16x8 aq = aqv[ks]; a1[ks] = col < 8 ? aq : zero; a2[ks] = col >= 8 ? aq : zero; }
#pragma unroll
        for (int nt = 0; nt < 8; ++nt) { pg8::f32x4 acc = {0.f, 0.f, 0.f, 0.f};
#pragma unroll
            for (int ks = 0; ks < 4; ++ks) {
                const rt_bf16x8 b1 = *(const LAS rt_bf16x8*)(keys + (16 * nt + col) * 272 + (ks * 32 + quad * 8) * 2);
                const rt_bf16x8 b2 = *(const LAS rt_bf16x8*)(keys + (128 + 16 * nt + col) * 272 + (ks * 32 + quad * 8) * 2);
                acc = __builtin_amdgcn_mfma_f32_16x16x32_bf16(a1[ks], b1, acc, 0, 0, 0);
                acc = __builtin_amdgcn_mfma_f32_16x16x32_bf16(a2[ks], b2, acc, 0, 0, 0); }
            uk[nt][0] = fkey(acc.x); uk[nt][1] = fkey(acc.y); uk[nt][2] = fkey(acc.z); uk[nt][3] = fkey(acc.w); }
    }
    {
        unsigned thr[4] = {0u, 0u, 0u, 0u}; unsigned fin = 0u; int bit0 = 31;
        {
            unsigned t0[4]; unsigned f0 = 0u; bool ok = true;
#pragma unroll
            for (int r = 0; r < 4; ++r) { unsigned mx = uk[0][r];
#pragma unroll
                for (int nt = 1; nt < 8; ++nt) mx = umaxu(mx, uk[nt][r]);
                t0[r] = row16_maxu(mx) & 0xFF000000u; int c = 0;
#pragma unroll
                for (int nt = 0; nt < 8; ++nt) c += (uk[nt][r] >= t0[r]) ? 1 : 0;
                c = row16_sum(c); ok = ok && (c >= 16); if (c == 16) f0 |= 1u << r; }
            if (__all(ok)) { thr[0] = t0[0]; thr[1] = t0[1]; thr[2] = t0[2]; thr[3] = t0[3]; fin = f0; bit0 = 23; }
        }
        for (int bit = bit0; bit >= 0; --bit) {
            if (__all(fin == 15u)) break;
            const unsigned m = 1u << bit;
#pragma unroll
            for (int r = 0; r < 4; ++r) { const unsigned cand = thr[r] | m; int c = 0;
#pragma unroll
                for (int nt = 0; nt < 8; ++nt) c += (uk[nt][r] >= cand) ? 1 : 0;
                c = row16_sum(c);
                const bool open = ((fin >> r) & 1u) == 0u;
                if (open && c >= 16) thr[r] = cand;
                if (open && c == 16) fin |= 1u << r; }
        }
        const bool ties = !__all(fin == 15u);
#pragma unroll
        for (int r = 0; r < 4; ++r) { const bool exact = ((fin >> r) & 1u) != 0u; const unsigned thrx = exact ? thr[r] - 1u : thr[r]; const int rowb = (4 * quad + r) * 16;
            int cl = 0;
#pragma unroll
            for (int nt = 0; nt < 8; ++nt) cl += (uk[nt][r] > thrx) ? 1 : 0;
            int p = row16_incl_scan(cl) - cl;
#pragma unroll
            for (int nt = 0; nt < 8; ++nt) if (uk[nt][r] > thrx) { if (p < 16) { Lv[rowb + p] = funkey(uk[nt][r]); Ln[rowb + p] = 16 * nt + col; } ++p; }
            if (ties) {
                const int tot = row16_sum(cl); int tl = 0;
#pragma unroll
                for (int nt = 0; nt < 8; ++nt) tl += (uk[nt][r] == thrx) ? 1 : 0;
                int p2 = tot + row16_incl_scan(tl) - tl;
#pragma unroll
                for (int nt = 0; nt < 8; ++nt) if (uk[nt][r] == thrx) { if (!exact && p2 < 16) { Lv[rowb + p2] = funkey(uk[nt][r]); Ln[rowb + p2] = 16 * nt + col; } ++p2; }
            }
        }
    }
    {
        const int hd = lane >> 3, sub = lane & 7;
        float v2[16];
#pragma unroll
        for (int i = 0; i < 4; ++i) { const f32x4 q = *(const LAS f32x4*)(Lv + (8 + hd) * 16 + 4 * i); v2[4 * i] = q.x; v2[4 * i + 1] = q.y; v2[4 * i + 2] = q.z; v2[4 * i + 3] = q.w; }
        const float v1a = Lv[hd * 16 + 2 * sub], v1b = Lv[hd * 16 + 2 * sub + 1];
        unsigned ck[32];
#pragma unroll
        for (int b = 0; b < 16; ++b) { ck[b] = fkey(v1a + v2[b]); ck[16 + b] = fkey(v1b + v2[b]); }
        unsigned thr = 0u; bool fin = false; int bit0 = 31;
        {   unsigned mx = ck[0];
#pragma unroll
            for (int i = 1; i < 32; ++i) mx = umaxu(mx, ck[i]);
            const unsigned t0 = grp8_maxu(mx) & 0xFF000000u; int c = 0;
#pragma unroll
            for (int i = 0; i < 32; ++i) c += (ck[i] >= t0) ? 1 : 0;
            c = grp8_sum(c);
            if (__all(c >= 16)) { thr = t0; fin = (c == 16); bit0 = 23; }
        }
        for (int bit = bit0; bit >= 0; --bit) {
            if (__all(fin)) break;
            const unsigned cand = thr | (1u << bit); int c = 0;
#pragma unroll
            for (int i = 0; i < 32; ++i) c += (ck[i] >= cand) ? 1 : 0;
            c = grp8_sum(c);
            if (!fin && c >= 16) thr = cand;
            if (!fin && c == 16) fin = true;
        }
        const bool ties = !__all(fin);
        const unsigned thrx = fin ? thr - 1u : thr;
        const int n1a = Ln[hd * 16 + 2 * sub], n1b = Ln[hd * 16 + 2 * sub + 1];
        int cl = 0;
#pragma unroll
        for (int i = 0; i < 32; ++i) cl += (ck[i] > thrx) ? 1 : 0;
        int p = grp8_incl_scan(cl, lane) - cl;
#pragma unroll
        for (int i = 0; i < 32; ++i) if (ck[i] > thrx) { if (p < 16) { idxs[hd * 16 + p] = (i < 16 ? n1a : n1b) * 128 + Ln[(8 + hd) * 16 + (i & 15)]; gs[hd * 16 + p] = funkey(ck[i]); } ++p; }
        if (ties) {
            const int tot = grp8_sum(cl); int tl = 0;
#pragma unroll
            for (int i = 0; i < 32; ++i) tl += (ck[i] == thrx) ? 1 : 0;
            int p2 = tot + grp8_incl_scan(tl, lane) - tl;
#pragma unroll
            for (int i = 0; i < 32; ++i) if (ck[i] == thrx) { if (!fin && p2 < 16) { idxs[hd * 16 + p2] = (i < 16 ? n1a : n1b) * 128 + Ln[(8 + hd) * 16 + (i & 15)]; gs[hd * 16 + p2] = funkey(ck[i]); } ++p2; }
        }
    }
    {
        const float s0 = gs[lane], s1 = gs[64 + lane];
        const float e0 = __expf(s0 - row16_maxf(s0)), e1 = __expf(s1 - row16_maxf(s1));
        gs[lane] = e0 / row16_sumf(e0); gs[64 + lane] = e1 / row16_sumf(e1);
    }
}

constexpr int PROW = 1024;
__device__ __forceinline__ void quant_load(f32x4 (&v)[8], const float* __restrict__ src, int lane) {
#pragma unroll
    for (int c = 0; c < 8; ++c) v[c] = *(const f32x4*)(src + 256 * c + 4 * lane);
}
__device__ __forceinline__ void quant_finish(const f32x4 (&v)[8], unsigned char* __restrict__ dst, bf16_t* __restrict__ scl, int lane, unsigned nibxor) {
    float am = 0.f;
#pragma unroll
    for (int i = 0; i < 8; ++i) am = fmaxf(am, fmaxf(fmaxf(fabsf(v[i].x), fabsf(v[i].y)), fmaxf(fabsf(v[i].z), fabsf(v[i].w))));
    am = fmaxf(am, dppf<0xB1>(am)); am = fmaxf(am, dppf<0x4E>(am)); am = fmaxf(am, dppf<0x141>(am)); am = fmaxf(am, dppf<0x140>(am)); am = fmaxf(am, __shfl_xor(am, 16)); am = fmaxf(am, __shfl_xor(am, 32));
    const unsigned sb = f2bf(am * (2.0f / 15.0f)); const float step = __uint_as_float(sb << 16);
    const float inv = step > 0.f ? 1.0f / step : 0.f;
    unsigned o[4];
#pragma unroll
    for (int d = 0; d < 4; ++d) { const f32x4 lo = v[2 * d], hi = v[2 * d + 1];
        const int l0 = min(max((int)rintf(lo.x * inv + 7.5f), 0), 15), l1 = min(max((int)rintf(lo.y * inv + 7.5f), 0), 15), l2 = min(max((int)rintf(lo.z * inv + 7.5f), 0), 15), l3 = min(max((int)rintf(lo.w * inv + 7.5f), 0), 15);
        const int h0 = min(max((int)rintf(hi.x * inv + 7.5f), 0), 15), h1 = min(max((int)rintf(hi.y * inv + 7.5f), 0), 15), h2 = min(max((int)rintf(hi.z * inv + 7.5f), 0), 15), h3 = min(max((int)rintf(hi.w * inv + 7.5f), 0), 15);
        o[d] = (unsigned)(l0 | (h0 << 4)) | ((unsigned)(l1 | (h1 << 4)) << 8) | ((unsigned)(l2 | (h2 << 4)) << 16) | ((unsigned)(l3 | (h3 << 4)) << 24); }
    u32x4 w; w.x = o[0] ^ nibxor; w.y = o[1] ^ nibxor; w.z = o[2] ^ nibxor; w.w = o[3] ^ nibxor;
    *(u32x4*)(dst + 16 * lane) = w;
    if (lane == 0) scl[0] = (bf16_t)sb;
}
__device__ __forceinline__ float rdl_f(float v, int l) { return __int_as_float(__builtin_amdgcn_readlane(__float_as_int(v), l)); }
template <int N> __device__ __forceinline__ void bfly_step(float (&s)[64], int lane) {
#pragma unroll
    for (int i = 0; i < N; ++i) { const bool up = (lane & N) != 0; const float keep = up ? s[i + N] : s[i], send = up ? s[i] : s[i + N]; s[i] = keep + __shfl_xor(send, N); }
}
__device__ __forceinline__ float bfly_reduce64(float (&p)[64], int lane) {
#pragma unroll
    for (int i = 0; i < 32; ++i) { auto r = __builtin_amdgcn_permlane32_swap(__float_as_uint(p[i]), __float_as_uint(p[i + 32]), false, false); p[i] = __uint_as_float(r[0]) + __uint_as_float(r[1]); }
    bfly_step<16>(p, lane); bfly_step<8>(p, lane); bfly_step<4>(p, lane); bfly_step<2>(p, lane); bfly_step<1>(p, lane);
    return p[0];
}
#define PEER_RING 16
#define PEER_R1 24
__device__ __forceinline__ float peer_quad4(float a0, float a1, float a2, float a3, int lane) {
    const bool b0 = (lane & 1) != 0, b1 = (lane & 2) != 0;
    const float u0 = (b0 ? a1 : a0) + dppf<0xB1>(b0 ? a0 : a1), u1 = (b0 ? a3 : a2) + dppf<0xB1>(b0 ? a2 : a3);
    return (b1 ? u1 : u0) + dppf<0x4E>(b1 ? u0 : u1);
}
__device__ __forceinline__ float peer_reduce16(float (&g)[16], int lane) {
#pragma unroll
    for (int i = 0; i < 8; ++i) { auto r = __builtin_amdgcn_permlane32_swap(__float_as_uint(g[i]), __float_as_uint(g[i + 8]), false, false); g[i] = __uint_as_float(r[0]) + __uint_as_float(r[1]); }
#pragma unroll
    for (int i = 0; i < 4; ++i) { const bool up = (lane & 16) != 0; const float keep = up ? g[i + 4] : g[i], send = up ? g[i] : g[i + 4]; g[i] = keep + __shfl_xor(send, 16); }
#pragma unroll
    for (int i = 0; i < 2; ++i) { const bool up = (lane & 8) != 0; const float keep = up ? g[i + 2] : g[i], send = up ? g[i] : g[i + 2]; g[i] = keep + __shfl_xor(send, 8); }
    { const bool up = (lane & 4) != 0; const float keep = up ? g[1] : g[0], send = up ? g[0] : g[1]; g[0] = keep + __shfl_xor(send, 4); }
    return g[0];
}
__device__ __forceinline__ int wave_sumi(int v) {
#pragma unroll
    for (int o = 1; o < 64; o <<= 1) v += __shfl_xor(v, o);
    return v; }
__device__ __forceinline__ int peer_quad4i(int a0, int a1, int a2, int a3, int lane) {
    const bool b0 = (lane & 1) != 0, b1 = (lane & 2) != 0;
    const int u0 = (b0 ? a1 : a0) + dppi<0xB1>(b0 ? a0 : a1), u1 = (b0 ? a3 : a2) + dppi<0xB1>(b0 ? a2 : a3);
    return (b1 ? u1 : u0) + dppi<0x4E>(b1 ? u0 : u1);
}
__device__ __forceinline__ int peer_reduce16i(int (&g)[16], int lane) {
#pragma unroll
    for (int i = 0; i < 8; ++i) { auto r = __builtin_amdgcn_permlane32_swap((unsigned)g[i], (unsigned)g[i + 8], false, false); g[i] = (int)(r[0] + r[1]); }
#pragma unroll
    for (int i = 0; i < 4; ++i) { const bool up = (lane & 16) != 0; const int keep = up ? g[i + 4] : g[i], send = up ? g[i] : g[i + 4]; g[i] = keep + __shfl_xor(send, 16); }
#pragma unroll
    for (int i = 0; i < 2; ++i) { const bool up = (lane & 8) != 0; const int keep = up ? g[i + 2] : g[i], send = up ? g[i] : g[i + 2]; g[i] = keep + __shfl_xor(send, 8); }
    { const bool up = (lane & 4) != 0; const int keep = up ? g[1] : g[0], send = up ? g[0] : g[1]; g[0] = keep + __shfl_xor(send, 4); }
    return g[0];
}
__device__ __forceinline__ int dot8z(int a, int b) { return __builtin_amdgcn_sdot8(a, b, 0, false); }
#define PEER_LD(slot, TB, e) do { const int e_ = (e); bx[slot] = *(const u32x4*)(TB##q + (size_t)e_ * PROW + 16 * lane); } while (0)
#define PEER_DOT(slot, dst) do { int aa_, ab_; \
        aa_ = dot8z((int)bx[slot].x, ha[0]); ab_ = dot8z((int)bx[slot].x, hb[0]); aa_ = __builtin_amdgcn_sdot8((int)bx[slot].y, ha[1], aa_, false); ab_ = __builtin_amdgcn_sdot8((int)bx[slot].y, hb[1], ab_, false); \
        aa_ = __builtin_amdgcn_sdot8((int)bx[slot].z, ha[2], aa_, false); ab_ = __builtin_amdgcn_sdot8((int)bx[slot].z, hb[2], ab_, false); aa_ = __builtin_amdgcn_sdot8((int)bx[slot].w, ha[3], aa_, false); ab_ = __builtin_amdgcn_sdot8((int)bx[slot].w, hb[3], ab_, false); \
        dst = 16 * aa_ + ab_; } while (0)
typedef _Float16 peer_h2 __attribute__((ext_vector_type(2)));
__device__ __forceinline__ float peer_dot2h(unsigned nn, unsigned cc, float acc) { return __builtin_amdgcn_fdot2(__builtin_bit_cast(peer_h2, nn), __builtin_bit_cast(peer_h2, cc), acc, false); }
#define PEER_ACC16(wa, wb, base) do { const unsigned la_ = (wa) & 0x0F0F0F0Fu, ha_ = (wa), lb_ = (wb) & 0x0F0F0F0Fu, hb_ = (wb);     \
        y[(base) + 0] = peer_dot2h(__builtin_amdgcn_perm(lb_, la_, 0x0C040C00u), cpair, y[(base) + 0]); y[(base) + 1] = peer_dot2h(__builtin_amdgcn_perm(lb_, la_, 0x0C050C01u), cpair, y[(base) + 1]); \
        y[(base) + 2] = peer_dot2h(__builtin_amdgcn_perm(lb_, la_, 0x0C060C02u), cpair, y[(base) + 2]); y[(base) + 3] = peer_dot2h(__builtin_amdgcn_perm(lb_, la_, 0x0C070C03u), cpair, y[(base) + 3]); \
        y[(base) + 4] = peer_dot2h(__builtin_amdgcn_perm(hb_, ha_, 0x0C040C00u), cpair, y[(base) + 4]); y[(base) + 5] = peer_dot2h(__builtin_amdgcn_perm(hb_, ha_, 0x0C050C01u), cpair, y[(base) + 5]); \
        y[(base) + 6] = peer_dot2h(__builtin_amdgcn_perm(hb_, ha_, 0x0C060C02u), cpair, y[(base) + 6]); y[(base) + 7] = peer_dot2h(__builtin_amdgcn_perm(hb_, ha_, 0x0C070C03u), cpair, y[(base) + 7]); } while (0)
__device__ __forceinline__ f32x4 x16_unpack(u32x2 p) { f32x4 r; r.x = __uint_as_float(p.x << 16); r.y = __uint_as_float(p.x & 0xffff0000u); r.z = __uint_as_float(p.y << 16); r.w = __uint_as_float(p.y & 0xffff0000u); return r; }
__device__ __forceinline__ float peer_gate(float tot, float sh, float g) { const float act = tot * sh; return 0.5f * act * (1.0f + erff(act * 0.70710678118654752f)) * g; }
__device__ __forceinline__ void peer_stage1(int lane, const LAS int* idxs, const LAS float* gs, const unsigned char* __restrict__ Uq, const bf16_t* __restrict__ Us, const bf16_t* __restrict__ Vs,
                                            const u32x2 (&xin)[8], const float* __restrict__ gain_ffn, LAS unsigned* save) {
    const int e0 = idxs[lane], e1 = idxs[64 + lane]; const float g0 = gs[lane], g1 = gs[64 + lane];
    u32x4 bx[PEER_R1];
    const float su0 = __uint_as_float((unsigned)Us[e0] << 16), su1 = __uint_as_float((unsigned)Us[e1] << 16), sv0 = __uint_as_float((unsigned)Vs[e0] << 16), sv1 = __uint_as_float((unsigned)Vs[e1] << 16);
#pragma unroll
    for (int s_ = 0; s_ < PEER_R1; ++s_) PEER_LD(s_, U, __builtin_amdgcn_readlane(e0, s_));
    __builtin_amdgcn_sched_barrier(0);
    float hf[32]; float am = 0.f;
    { float ssx = 0.f;
#pragma unroll
      for (int c = 0; c < 8; ++c) { const f32x4 xv = x16_unpack(xin[c]); hf[4 * c] = xv.x; hf[4 * c + 1] = xv.y; hf[4 * c + 2] = xv.z; hf[4 * c + 3] = xv.w;
          ssx += (xv.x * xv.x + xv.y * xv.y) + (xv.z * xv.z + xv.w * xv.w); }
      const float rx = 1.0f / sqrtf(wave_sum(ssx) * (1.0f / D) + EPS);
#pragma unroll
      for (int c = 0; c < 8; ++c) { const f32x4 gv = *(const f32x4*)(gain_ffn + 256 * c + 4 * lane); hf[4 * c] *= rx * gv.x; hf[4 * c + 1] *= rx * gv.y; hf[4 * c + 2] *= rx * gv.z; hf[4 * c + 3] *= rx * gv.w; } }
#pragma unroll
    for (int i = 0; i < 32; ++i) am = fmaxf(am, fabsf(hf[i]));
    am = wave_max(am);
    const float inv = am > 0.f ? 119.0f / am : 0.f, sh = am * (1.0f / 119.0f);
    int ha[4], hb[4]; int hsum = 0;
#pragma unroll
    for (int d = 0; d < 4; ++d) { unsigned pa_ = 0u, pb_ = 0u;
#pragma unroll
        for (int e = 0; e < 8; ++e) { const int q = (int)rintf(hf[8 * d + e] * inv); const int a_ = (q + 8) >> 4, b_ = q - 16 * a_; hsum += q;
            const int sh_ = (e < 4) ? 8 * e : 8 * (e - 4) + 4; pa_ |= ((unsigned)a_ & 15u) << sh_; pb_ |= ((unsigned)b_ & 15u) << sh_; }
        ha[d] = (int)pa_; hb[d] = (int)pb_; }
    const float hoff = 0.5f * (float)wave_sumi(hsum);
    float a0, a1;
    { int g[16], pa[4];
#pragma unroll
      for (int k = 0; k < 64; ++k) { PEER_DOT(k % PEER_R1, pa[k & 3]);
          if (k + PEER_R1 < 64) PEER_LD(k % PEER_R1, U, __builtin_amdgcn_readlane(e0, k + PEER_R1)); else PEER_LD(k % PEER_R1, U, __builtin_amdgcn_readlane(e1, k + PEER_R1 - 64));
          if ((k & 3) == 3) g[k >> 2] = peer_quad4i(pa[0], pa[1], pa[2], pa[3], lane);
          __builtin_amdgcn_sched_barrier(0); }
      a0 = peer_gate(((float)peer_reduce16i(g, lane) + hoff) * su0, sh, g0) * sv0; }
    { int g[16], pa[4];
#pragma unroll
      for (int k = 0; k < 64; ++k) { PEER_DOT((64 + k) % PEER_R1, pa[k & 3]);
          if (64 + k + PEER_R1 < 128) PEER_LD((64 + k) % PEER_R1, U, __builtin_amdgcn_readlane(e1, k + PEER_R1));
          if ((k & 3) == 3) g[k >> 2] = peer_quad4i(pa[0], pa[1], pa[2], pa[3], lane);
          __builtin_amdgcn_sched_barrier(0); }
      a1 = peer_gate(((float)peer_reduce16i(g, lane) + hoff) * su1, sh, g1) * sv1; }
    save[lane] = (unsigned)e0 | ((unsigned)e1 << 16); save[64 + lane] = __float_as_uint(a0); save[128 + lane] = __float_as_uint(a1);
}
__device__ __forceinline__ void peer_stage3(int t, int lane, const LAS unsigned* save, const unsigned char* __restrict__ Vq, bf16_t* __restrict__ x16, bf16_t* __restrict__ h,
                                            const float* __restrict__ gain_next, float* __restrict__ out_final) {
    constexpr int PEER_S3 = 0;
    const unsigned ee = save[lane]; const int e0 = (int)(ee & 0xffffu), e1 = (int)(ee >> 16); const float a0 = __uint_as_float(save[64 + lane]), a1 = __uint_as_float(save[128 + lane]);
    u32x4 bx[PEER_RING];
#pragma unroll
    for (int s_ = 0; s_ < PEER_RING; ++s_) PEER_LD(s_, V, __builtin_amdgcn_readlane(e0, s_));
    __builtin_amdgcn_sched_barrier(0);
    float y[32]; float csum = 0.f;
#pragma unroll
    for (int i = 0; i < 32; ++i) y[i] = 0.f;
    for (int kk = 0; kk < 128 - PEER_RING; kk += PEER_RING) {
#pragma unroll
        for (int s_ = 0; s_ < PEER_RING; s_ += 2) { const int k = kk + s_;
            const float cka = rdl_f(k < 64 ? a0 : a1, k & 63), ckb = rdl_f(k < 64 ? a0 : a1, (k + 1) & 63);
            const unsigned cpair = __builtin_bit_cast(unsigned, __builtin_amdgcn_cvt_pkrtz(cka, ckb));
            PEER_ACC16(bx[PEER_S3 + s_].x, bx[PEER_S3 + s_ + 1].x, 0); PEER_ACC16(bx[PEER_S3 + s_].y, bx[PEER_S3 + s_ + 1].y, 8); PEER_ACC16(bx[PEER_S3 + s_].z, bx[PEER_S3 + s_ + 1].z, 16); PEER_ACC16(bx[PEER_S3 + s_].w, bx[PEER_S3 + s_ + 1].w, 24);
            csum = peer_dot2h(cpair, 0x3C003C00u, csum);
            const int kn = k + PEER_RING;
            if (kn < 128) { PEER_LD(PEER_S3 + s_, V, __builtin_amdgcn_readlane(kn < 64 ? e0 : e1, kn & 63)); PEER_LD(PEER_S3 + s_ + 1, V, __builtin_amdgcn_readlane(kn < 64 ? e0 : e1, (kn + 1) & 63)); }
            __builtin_amdgcn_sched_barrier(0); }
    }
    u32x2 xe[8]; { const bf16_t* xr1 = x16 + (size_t)t * D + 4 * lane;
#pragma unroll
      for (int c = 0; c < 8; ++c) xe[c] = *(const u32x2*)(xr1 + 256 * c); }
    __builtin_amdgcn_sched_barrier(0);
    { const int kk = 128 - PEER_RING;
#pragma unroll
        for (int s_ = 0; s_ < PEER_RING; s_ += 2) { const int k = kk + s_;
            const float cka = rdl_f(k < 64 ? a0 : a1, k & 63), ckb = rdl_f(k < 64 ? a0 : a1, (k + 1) & 63);
            const unsigned cpair = __builtin_bit_cast(unsigned, __builtin_amdgcn_cvt_pkrtz(cka, ckb));
            PEER_ACC16(bx[PEER_S3 + s_].x, bx[PEER_S3 + s_ + 1].x, 0); PEER_ACC16(bx[PEER_S3 + s_].y, bx[PEER_S3 + s_ + 1].y, 8); PEER_ACC16(bx[PEER_S3 + s_].z, bx[PEER_S3 + s_ + 1].z, 16); PEER_ACC16(bx[PEER_S3 + s_].w, bx[PEER_S3 + s_ + 1].w, 24);
            csum = peer_dot2h(cpair, 0x3C003C00u, csum);
            const int kn = k + PEER_RING;
            if (kn < 128) { PEER_LD(PEER_S3 + s_, V, __builtin_amdgcn_readlane(kn < 64 ? e0 : e1, kn & 63)); PEER_LD(PEER_S3 + s_ + 1, V, __builtin_amdgcn_readlane(kn < 64 ? e0 : e1, (kn + 1) & 63)); }
            __builtin_amdgcn_sched_barrier(0); }
    }
    bf16_t* xr = x16 + (size_t)t * D + 4 * lane; float ss = 0.f;
#pragma unroll
    for (int c = 0; c < 8; c += 2) { const f32x4 xl = x16_unpack(xe[c]), xh = x16_unpack(xe[c + 1]); const int b = 4 * c; const float off = 7.5f * csum;
        const float h0 = (y[b + 4] - y[b]) * 1048576.0f - off + xh.x, h1 = (y[b + 5] - y[b + 1]) * 1048576.0f - off + xh.y, h2 = (y[b + 6] - y[b + 2]) * 1048576.0f - off + xh.z, h3 = (y[b + 7] - y[b + 3]) * 1048576.0f - off + xh.w;
        y[b] = y[b] * 16777216.0f - off + xl.x; y[b + 1] = y[b + 1] * 16777216.0f - off + xl.y; y[b + 2] = y[b + 2] * 16777216.0f - off + xl.z; y[b + 3] = y[b + 3] * 16777216.0f - off + xl.w;
        y[b + 4] = h0; y[b + 5] = h1; y[b + 6] = h2; y[b + 7] = h3; }
#pragma unroll
    for (int i = 0; i < 32; ++i) ss += y[i] * y[i];
    const float r = 1.0f / sqrtf(wave_sum(ss) * (1.0f / D) + EPS);
    float gn[32];
#pragma unroll
    for (int c = 0; c < 8; ++c) { const f32x4 gv = *(const f32x4*)(gain_next + 256 * c + 4 * lane); gn[4 * c] = gv.x; gn[4 * c + 1] = gv.y; gn[4 * c + 2] = gv.z; gn[4 * c + 3] = gv.w; }
    if (out_final) {
#pragma unroll
        for (int c = 0; c < 8; ++c) { const int b = 4 * c; f32x4 o; o.x = y[b] * r * gn[b]; o.y = y[b + 1] * r * gn[b + 1]; o.z = y[b + 2] * r * gn[b + 2]; o.w = y[b + 3] * r * gn[b + 3];
            *(f32x4*)(out_final + (size_t)t * D + 256 * c + 4 * lane) = o; }
    } else {
#pragma unroll
        for (int c = 0; c < 8; ++c) { const int b = 4 * c; u32x2 o; o.x = pk2(y[b], y[b + 1]); o.y = pk2(y[b + 2], y[b + 3]); *(u32x2*)(xr + 256 * c) = o; }
        bf16_t* hp = h + (size_t)t * D + 4 * lane;
#pragma unroll
        for (int c = 0; c < 8; ++c) { const int b = 4 * c; u32x2 o; o.x = pk2(y[b] * r * gn[b], y[b + 1] * r * gn[b + 1]); o.y = pk2(y[b + 2] * r * gn[b + 2], y[b + 3] * r * gn[b + 3]);
            *(u32x2*)(hp + 256 * c) = o; }
    }
}

template <class Tp> __device__ __forceinline__ Tp* launder(Tp* p) { size_t z = 0; asm volatile("" : "+s"(z)); return (Tp*)((char*)p + z); }
__device__ __forceinline__ int opqv(int v) { asm volatile("" : "+v"(v)); return v; }
__device__ __forceinline__ int opq(int v) { asm volatile("" : "+s"(v)); return v; }
#define WSP(type, off) ((type*)(w_ + (off)))
#define XB_T0() (wave == 0 && __builtin_amdgcn_mbcnt_hi((unsigned)opq(-1), __builtin_amdgcn_mbcnt_lo((unsigned)opq(-1), 0u)) == 0u)
#define PHASE_BASE() unsigned char* w_ = launder(ws); const unsigned ones_ = (unsigned)opq(-1); const int lane = (int)__builtin_amdgcn_mbcnt_hi(ones_, __builtin_amdgcn_mbcnt_lo(ones_, 0u)), tid = wave * 64 + lane, gw = blockIdx.x * 8 + wave; (void)tid; (void)gw
#define INP(i) launder(a.in[i])

constexpr int LDS_TAB = 131072;
constexpr int TAB_MAX = 10;
__device__ __forceinline__ float sum8f(const float* p) { const f32x4 a = *(const f32x4*)p, b = *(const f32x4*)(p + 4); return ((a.x + a.y) + (a.z + a.w)) + ((b.x + b.y) + (b.z + b.w)); }
__device__ __forceinline__ float rs1024(float ssq) { return 1.0f / sqrtf(ssq * (1.0f / 1024.0f) + EPS); }
struct EpiResid2 {
    static constexpr bool PERM = true, AFTER_DRAIN = false; static constexpr int KSPLIT = 2;
    bf16_t* X; float* xp; const float* mp; const float* np; const LAS float* tab;
    __device__ __forceinline__ void scales(int ord, int row, int rloc, float& ratio, float& s2) const {
        if (ord < TAB_MAX) { const LAS float* t = tab + ord * 512 + rloc * 2; ratio = t[0]; s2 = t[1]; }
        else { const float s1 = rs1024(sum8f(mp + (size_t)row * 8)); s2 = rs1024(sum8f(np + (size_t)row * 8)); ratio = s1 / s2; } }
    __device__ __forceinline__ void mid(pg8::f32x4 (&acc)[2][2][4][2], const pg8::Unit& u, int wr, int wc, int fr, int fq, int ord) const {
        const int rl0 = opqv(wr * 64 + fr);
#pragma unroll
        for (int ai = 0; ai < 2; ++ai)
#pragma unroll
            for (int m = 0; m < 4; ++m) { const int rloc = rl0 + ai * 128 + m * 16; float ratio, s2; scales(ord, u.pm * 256 + rloc, rloc, ratio, s2);
#pragma unroll
                for (int bj = 0; bj < 2; ++bj)
#pragma unroll
                    for (int n = 0; n < 2; ++n) acc[ai][bj][m][n] = acc[ai][bj][m][n] * ratio; }
    }
    __device__ __forceinline__ void operator()(const pg8::f32x4 (&acc)[2][2][4][2], const pg8::Unit& u, int wr, int wc, int fr, int fq, int ord) const {
        const int rl0 = opqv(wr * 64 + fr), row0 = u.pm * 256 + rl0, col0 = u.pn * 256 + wc * 32 + 8 * fq;
#pragma unroll
        for (int ai = 0; ai < 2; ++ai) {
            u32x4 xv[4][2];
#pragma unroll
            for (int m = 0; m < 4; ++m) { const bf16_t* rowp = X + (size_t)(row0 + ai * 128 + m * 16) * D + col0;
#pragma unroll
                for (int bj = 0; bj < 2; ++bj) xv[m][bj] = *(const u32x4*)(rowp + bj * 128); }
            asm volatile("" ::: "memory");
#pragma unroll
            for (int m = 0; m < 4; ++m) { const int rloc = rl0 + ai * 128 + m * 16, row = u.pm * 256 + rloc; bf16_t* rowp = X + (size_t)row * D + col0; float ss = 0.f; float ratio_, s2; scales(ord, row, rloc, ratio_, s2); (void)ratio_;
#pragma unroll
                for (int bj = 0; bj < 2; ++bj) { const u32x4 p = xv[m][bj]; const f32x4 a0 = acc[ai][bj][m][0] * s2, a1 = acc[ai][bj][m][1] * s2;
                    u32x4 w; w.x = pk2(__uint_as_float(p.x << 16) + a0.x, __uint_as_float(p.x & 0xffff0000u) + a0.y); w.y = pk2(__uint_as_float(p.y << 16) + a0.z, __uint_as_float(p.y & 0xffff0000u) + a0.w);
                    w.z = pk2(__uint_as_float(p.z << 16) + a1.x, __uint_as_float(p.z & 0xffff0000u) + a1.y); w.w = pk2(__uint_as_float(p.w << 16) + a1.z, __uint_as_float(p.w & 0xffff0000u) + a1.w);
                    *(u32x4*)(rowp + bj * 128) = w;
#pragma unroll
                    for (int q = 0; q < 4; ++q) { const float lo = __uint_as_float(w[q] << 16), hi = __uint_as_float(w[q] & 0xffff0000u); ss += lo * lo + hi * hi; } }
                ss += __shfl_xor(ss, 16); ss += __shfl_xor(ss, 32);
                if (fq == 0) xp[(size_t)row * 32 + u.pn * 4 + wc] = ss; }
        }
    }
};
__device__ __forceinline__ void pf_tables(LAS float* tab, const float* __restrict__ mp, const float* __restrict__ np, const pg8::StaticOrder& S, int tid) {
    pg8::Unit u;
    for (int i = 0; i < 2 * TAB_MAX; i += 2) { if (!S.next(i / 2, u)) break;
        if (tid < 256) { const int row = u.pm * 256 + tid; const float s1 = rs1024(sum8f(mp + (size_t)row * 8)), s2 = rs1024(sum8f(np + (size_t)row * 8)); tab[(i / 2) * 512 + tid * 2] = s1 / s2; tab[(i / 2) * 512 + tid * 2 + 1] = s2; } }
}
struct EpiKV {
    static constexpr bool PERM = true, AFTER_DRAIN = false, ORD = true;
    bf16_t* O; const LAS float* tab; const float* lp;
    __device__ __forceinline__ void operator()(const pg8::f32x4 (&acc)[2][2][4][2], const pg8::Unit& u, int wr, int wc, int fr, int fq, int ord) const {
        const int rl0 = opqv(wr * 64 + fr); int colt = u.pn * 256; bf16_t* base = O;
        if (colt >= 1024) { base += (size_t)T * 1024; colt -= 1024; }
        const int col0 = colt + wc * 32 + 8 * fq;
#pragma unroll
        for (int ai = 0; ai < 2; ++ai)
#pragma unroll
            for (int m = 0; m < 4; ++m) { const int rloc = rl0 + ai * 128 + m * 16, row = u.pm * 256 + rloc; const float r = ord < 20 ? tab[ord * 256 + rloc] : lat_scale(lp + (size_t)row * 16 + 8, 4, 256.0f); bf16_t* rowp = base + (size_t)row * 1024 + col0;
#pragma unroll
                for (int bj = 0; bj < 2; ++bj) { const f32x4 v0 = acc[ai][bj][m][0] * r, v1 = acc[ai][bj][m][1] * r;
                    u32x4 w; w.x = pk2(v0.x, v0.y); w.y = pk2(v0.z, v0.w); w.z = pk2(v1.x, v1.y); w.w = pk2(v1.z, v1.w);
                    *(u32x4*)(rowp + bj * 128) = w; } }
    }
};
__device__ __forceinline__ void lat_tables(LAS float* tab, const float* __restrict__ lp, int off, int n, float dim, const pg8::StaticOrder& S, int tid) {
    pg8::Unit u;
    for (int i = 0; i < 20; ++i) { if (!S.next(i, u)) break;
        if (tid < 256) tab[i * 256 + tid] = lat_scale(lp + (size_t)(u.pm * 256 + tid) * 16 + off, n, dim); }
}
struct EpiRowScale {
    static constexpr bool PERM = true, AFTER_DRAIN = false, ORD = true;
    bf16_t* O; const float* xp; const LAS float* tab; int ldc, pad;
    static __device__ __forceinline__ float rowscale(const float* p) { float t = 0.f;
#pragma unroll
        for (int i = 0; i < 4; ++i) t += sum8f(p + 8 * i);
        return 1.0f / sqrtf(t * (1.0f / D) + EPS); }
    __device__ __forceinline__ void operator()(const pg8::f32x4 (&acc)[2][2][4][2], const pg8::Unit& u, int wr, int wc, int fr, int fq, int ord) const {
        const int rl0 = opqv(wr * 64 + fr), col0 = u.pn * 256 + wc * 32 + 8 * fq;
#pragma unroll
        for (int ai = 0; ai < 2; ++ai)
#pragma unroll
            for (int m = 0; m < 4; ++m) { const int rloc = rl0 + ai * 128 + m * 16, row = u.pm * 256 + rloc; const float r = ord < 2 * TAB_MAX ? tab[ord * 256 + rloc] : rowscale(xp + (size_t)row * 32); bf16_t* rowp = O + (size_t)row * ldc + col0;
#pragma unroll
                for (int bj = 0; bj < 2; ++bj) { const f32x4 v0 = acc[ai][bj][m][0] * r, v1 = acc[ai][bj][m][1] * r;
                    u32x4 w; w.x = pk2(v0.x, v0.y); w.y = pk2(v0.z, v0.w); w.z = pk2(v1.x, v1.y); w.w = pk2(v1.z, v1.w);
                    *(u32x4*)(rowp + bj * 128) = w; } }
    }
};
__device__ __forceinline__ void ph_tables(LAS float* tab, const float* __restrict__ xp, const pg8::StaticOrder& S, int tid) {
    pg8::Unit u;
    for (int i = 0; i < 2 * TAB_MAX; ++i) { if (!S.next(i, u)) break;
        if (tid < 256) tab[i * 256 + tid] = EpiRowScale::rowscale(xp + (size_t)(u.pm * 256 + tid) * 32); }
}
__global__ void __launch_bounds__(512, 2) mk_fwd(MkArgs a) {
    extern __shared__ __attribute__((aligned(16))) unsigned char lds_raw[];
    LAS unsigned char* lds = (LAS unsigned char*)lds_raw;
    const int tid0 = threadIdx.x, wave = __builtin_amdgcn_readfirstlane(tid0 >> 6);
    const int G = gridDim.x, NGW = G * 8;
    unsigned char* ws = a.ws;
    if (tid0 < 4) ((LAS unsigned*)(lds + LDS_BAR_OFF))[tid0] = 0u;
    __syncthreads();
    XcdBarrier bar = xcd_barrier_post((unsigned*)(ws + WS_CTL), (volatile LAS unsigned*)(lds + LDS_BAR_OFF));

    {
        PHASE_BASE(); LAS float* scr = (LAS float*)(lds + wave * 16384);
        unsigned* KT = WSP(unsigned, WS_KT); float* rope = WSP(float, WS_ROPE); const float* sk = INP(13);
        conv_w_all(INP(2), WSP(bf16_t, WS_WIN), D, DIN, DINP, 0, scr, gw, NGW, lane);
        conv_w_all(INP(4), WSP(bf16_t, WS_WUQ), 512, 1536, 1536, 1, scr, gw, NGW, lane, INP(3));
        conv_w_all(INP(6), WSP(bf16_t, WS_WUKV), 256, 2048, 2048, 2, scr, gw, NGW, lane, INP(5));
        conv_w_all(INP(10), WSP(bf16_t, WS_WOUT), D, D, D, 3, scr, gw, NGW, lane, INP(8), INP(9));
        conv_w_all(INP(12), WSP(bf16_t, WS_WPQ), D, D, D, 3, scr, gw, NGW, lane, INP(11));
        const size_t gt = (size_t)blockIdx.x * 512 + tid, NGT = (size_t)G * 512;
        { const float* pu = INP(14); const float* pv = INP(15); unsigned char* Uq = WSP(unsigned char, WS_U); unsigned char* Vq = WSP(unsigned char, WS_V); bf16_t* Us = WSP(bf16_t, WS_US); bf16_t* Vs = WSP(bf16_t, WS_VS);
          for (int r = gw; r < NL * 16384; r += 2 * NGW) {
              const int r2 = r + NGW; f32x4 a0[8], b0[8], a1[8], b1[8];
              quant_load(a0, pu + (size_t)r * D, lane); quant_load(b0, pv + (size_t)r * D, lane); const bool two = r2 < NL * 16384; if (two) { quant_load(a1, pu + (size_t)r2 * D, lane); quant_load(b1, pv + (size_t)r2 * D, lane); }
              quant_finish(a0, Uq + (size_t)r * PROW, Us + (size_t)r, lane, 0x88888888u); quant_finish(b0, Vq + (size_t)r * PROW, Vs + (size_t)r, lane, 0u);
              if (two) { quant_finish(a1, Uq + (size_t)r2 * PROW, Us + (size_t)r2, lane, 0x88888888u); quant_finish(b1, Vq + (size_t)r2 * PROW, Vs + (size_t)r2, lane, 0u); } } }
        conv_bf16_all(sk, (bf16_t*)KT, (size_t)NL * 2 * 128 * 128 / 8, gt, NGT);
        for (size_t i = gt; i < (size_t)SEQ * 32; i += NGT) { const int s = (int)i >> 5, j = (int)i & 31;
            double rev = (double)s * ROPE_REV[j]; rev -= __builtin_rint(rev); const float r = (float)rev;
            rope[s * 64 + j] = __builtin_amdgcn_cosf(r); rope[s * 64 + 32 + j] = __builtin_amdgcn_sinf(r); }
        { const float* x = INP(0); const float* attn_norm = INP(1); bf16_t* h = WSP(bf16_t, WS_H); bf16_t* x16 = WSP(bf16_t, WS_X32);
          for (int t = gw; t < T; t += NGW) norm_x_row(x + (size_t)t * D, attn_norm, h + (size_t)t * D, x16 + (size_t)t * D, lane); }
    }
    xcd_barrier(bar, XB_T0());

    const float qscale = 0.07216878364870322f;
    for (int l = 0; l < NL; ++l) {
        { PHASE_BASE();
          pg8::Gemm g{WSP(bf16_t, WS_H), WSP(bf16_t, WS_WIN) + (size_t)l * DINP * D, T, DINP, opq(D), 0};
          EpiIn E{WSP(bf16_t, WS_CQ), WSP(bf16_t, WS_CKV), WSP(bf16_t, WS_NQ), WSP(bf16_t, WS_NK), WSP(bf16_t, WS_NV), WSP(bf16_t, WS_KPE), WSP(float, WS_ROPE), WSP(float, WS_LP)};
          pg8::StaticOrder S; S.init(T, DINP, G, (int)blockIdx.x);
          pg8::gemm_phase<EpiIn, pg8::StaticOrder>(lds, g, S, E, nullptr, wave); }
        xcd_barrier(bar, XB_T0());
        { PHASE_BASE(); pg8::Gemm g{WSP(bf16_t, WS_CQ), WSP(bf16_t, WS_WUQ) + (size_t)l * 1536 * 512, T, 1536, opq(512), 0}; EpiQ E{WSP(bf16_t, WS_Q), WSP(float, WS_ROPE), (const LAS float*)(lds + LDS_TAB), WSP(float, WS_LP), qscale, 0};
          pg8::StaticOrder S; S.init(T, 1536, G, (int)blockIdx.x);
          lat_tables((LAS float*)(lds + LDS_TAB), WSP(float, WS_LP), 0, 8, 512.0f, S, tid); __syncthreads();
          pg8::gemm_phase<EpiQ, pg8::StaticOrder>(lds, g, S, E, nullptr, wave); }
        { PHASE_BASE(); pg8::Gemm g{WSP(bf16_t, WS_CKV), WSP(bf16_t, WS_WUKV) + (size_t)l * 2048 * 256, T, 2048, opq(256), 0}; EpiKV E{WSP(bf16_t, WS_KN), (const LAS float*)(lds + LDS_TAB), WSP(float, WS_LP)};
          pg8::StaticOrder S; S.init(T, 2048, G, (int)blockIdx.x);
          __syncthreads(); lat_tables((LAS float*)(lds + LDS_TAB), WSP(float, WS_LP), 8, 4, 256.0f, S, tid); __syncthreads();
          pg8::gemm_phase<EpiKV, pg8::StaticOrder>(lds, g, S, E, nullptr, wave); }
        {
            PHASE_BASE(); LAS float* rp = (LAS float*)(lds + natm::OFF_RP); const float* rpb = INP(7);
            bf16_t* nq = WSP(bf16_t, WS_NQ); bf16_t* nk = WSP(bf16_t, WS_NK); bf16_t* nv = WSP(bf16_t, WS_NV); bf16_t* mix = WSP(bf16_t, WS_MIX); float* nss = WSP(float, WS_NP);
            __syncthreads();
            for (int i = tid; i < 16 * 15 * 31; i += 512) rp[i] = rpb[(size_t)l * 7440 + i];
            const int vcu = (G % 8 == 0) ? ((int)blockIdx.x % 8) * (G / 8) + (int)blockIdx.x / 8 : (int)blockIdx.x;
            for (int u = vcu; u < 512; u += G) { __syncthreads(); natm::nat_unit(u, opqv(tid), nq, nk, nv, mix + 1024, nss, (LAS char*)lds); }
        }
        xcd_barrier(bar, XB_T0());
        { PHASE_BASE(); const int vcu = (G % 8 == 0) ? ((int)blockIdx.x % 8) * (G / 8) + (int)blockIdx.x / 8 : (int)blockIdx.x;
          const bf16_t* Q = WSP(bf16_t, WS_Q); const bf16_t* Kn = WSP(bf16_t, WS_KN); const bf16_t* Vv = WSP(bf16_t, WS_VV); const bf16_t* kpe = WSP(bf16_t, WS_KPE); bf16_t* mix = WSP(bf16_t, WS_MIX); float* mss = WSP(float, WS_MP);
          for (int u = vcu; u < 512; u += G) { const int qblk = u & 7, hd = (u >> 3) & 7, b = u >> 6; const size_t t0 = (size_t)b * 2048;
            __syncthreads();
            mla::attn_unit(opqv(tid), Q + (t0 + qblk * 256) * 1536 + hd * 192, Kn + t0 * 1024 + hd * 128, Vv + t0 * 1024 + hd * 128, kpe + t0 * 64, mix + (t0 + qblk * 256) * 2048 + hd * 128, mss + (t0 + qblk * 256) * 8 + hd, (LAS char*)lds); } }
        xcd_barrier(bar, XB_T0());
        { PHASE_BASE(); pg8::Gemm g{WSP(bf16_t, WS_MIX), WSP(bf16_t, WS_WOUT) + (size_t)l * D * D, T, D, opq(D), 0}; EpiResid2 E{WSP(bf16_t, WS_X32), WSP(float, WS_XP), WSP(float, WS_MP), WSP(float, WS_NP), (const LAS float*)(lds + LDS_TAB)};
          pg8::StaticOrder S; S.init(T, D, G, (int)blockIdx.x);
          pf_tables((LAS float*)(lds + LDS_TAB), WSP(float, WS_MP), WSP(float, WS_NP), S, tid); __syncthreads();
          pg8::gemm_phase<EpiResid2, pg8::StaticOrder>(lds, g, S, E, nullptr, wave); }
        xcd_barrier(bar, XB_T0());
        { PHASE_BASE(); pg8::Gemm g{WSP(bf16_t, WS_X32), WSP(bf16_t, WS_WPQ) + (size_t)l * D * D, T, D, opq(D), 0}; EpiRowScale E{WSP(bf16_t, WS_PQ), WSP(float, WS_XP), (const LAS float*)(lds + LDS_TAB), D, 0};
          pg8::StaticOrder S; S.init(T, D, G, (int)blockIdx.x);
          ph_tables((LAS float*)(lds + LDS_TAB), WSP(float, WS_XP), S, tid); __syncthreads();
          pg8::gemm_phase<EpiRowScale, pg8::StaticOrder>(lds, g, S, E, nullptr, wave); }
        xcd_barrier(bar, XB_T0());
        {
            PHASE_BASE(); LAS unsigned char* keys = lds; const bf16_t* KB = WSP(bf16_t, WS_KT) + (size_t)l * 2 * 128 * 128; const float* final_norm = INP(16); const float* attn_norm = INP(1); const float* ffn_norm = INP(11);
            bf16_t* pq = WSP(bf16_t, WS_PQ); const unsigned char* Uq = WSP(unsigned char, WS_U); const unsigned char* Vq = WSP(unsigned char, WS_V); bf16_t* x16 = WSP(bf16_t, WS_X32); bf16_t* h = WSP(bf16_t, WS_H);
            LAS float* Lv = (LAS float*)(lds + 69632 + wave * 4096); LAS int* Ln = (LAS int*)(Lv + 256); LAS int* idxs = Ln + 256; LAS float* gs = (LAS float*)(idxs + 128);
            for (int i = tid; i < 256 * 16; i += 512) { const int row = i >> 4, ch = i & 15; *(LAS u32x4*)(keys + row * 272 + ch * 16) = *(const u32x4*)(KB + row * 128 + ch * 8); }
            __syncthreads();
            const bool last = (l == NL - 1);
            LAS unsigned* save = (LAS unsigned*)(lds + 102400 + wave * 6144);
            const bool aff_ = (G == 256); const int tstr_ = aff_ ? 256 : NGW, tb0_ = aff_ ? 2048 * ((int)blockIdx.x & 7) + ((int)blockIdx.x >> 3) * 8 + wave : gw;
            for (int tb = tb0_, nb2_ = 0; aff_ ? nb2_ < 1 : tb < T; tb += 8 * NGW, ++nb2_) {
                { int nt = 0;
                  for (int t = tb; t < T && nt < 8; t += tstr_, ++nt) { const int ln = opqv(lane); rt_bf16x8 aq[4]; peer_load_q(t, ln, pq, aq);
                    u32x2 xin[8];
                    { const bf16_t* xr0 = x16 + (size_t)t * D + 4 * ln;
#pragma unroll
                      for (int c = 0; c < 8; ++c) xin[c] = *(const u32x2*)(xr0 + 256 * c); }
                    __builtin_amdgcn_sched_barrier(0);
                    peer_route(ln, keys, Lv, Ln, idxs, gs, aq);
                    peer_stage1(ln, idxs, gs, Uq + (size_t)l * 16384 * PROW, WSP(bf16_t, WS_US) + (size_t)l * 16384, WSP(bf16_t, WS_VS) + (size_t)l * 16384, xin, ffn_norm + l * D, save + nt * 192); } }
                { int nt = 0;
                  for (int t = tb; t < T && nt < 8; t += tstr_, ++nt) { const int ln = opqv(lane);
                    peer_stage3(t, ln, save + nt * 192, Vq + (size_t)l * 16384 * PROW, x16, h, last ? final_norm : attn_norm + (l + 1) * D, last ? a.out : nullptr); } }
            }
        }
        if (l + 1 < NL) xcd_barrier(bar, XB_T0());
    }
}

extern "C" void kernel_launch(void* const* d_in, const int* in_sizes, int n_in, void* d_out, int out_size, void* d_ws, size_t ws_size, hipStream_t stream) {
    static int grid = 0;
    if (grid == 0) {
        if (n_in != 17 || ws_size < WS_END) { fprintf(stderr, "kernel_launch: unexpected n_in %d / ws_size %zu (need %zu)\n", n_in, ws_size, (size_t)WS_END); grid = -1; return; }
        int dev = 0, cus = 0, per_cu = 0;
        if (hipGetDevice(&dev) != hipSuccess || hipDeviceGetAttribute(&cus, hipDeviceAttributeMultiprocessorCount, dev) != hipSuccess) { grid = -1; return; }
        if (hipFuncSetAttribute((const void*)mk_fwd, hipFuncAttributeMaxDynamicSharedMemorySize, LDS_BYTES) != hipSuccess) { fprintf(stderr, "kernel_launch: hipFuncSetAttribute failed\n"); grid = -1; return; }
        if (hipOccupancyMaxActiveBlocksPerMultiprocessor(&per_cu, (const void*)mk_fwd, 512, LDS_BYTES) != hipSuccess || per_cu < 1) { fprintf(stderr, "kernel_launch: occupancy query says %d\n", per_cu); }
        (void)hipGetLastError();
        grid = cus;
    }
    if (grid < 0) return;
    (void)hipMemsetAsync((char*)d_ws + WS_CTL, 0, XCD_BAR_WORDS * sizeof(unsigned), stream);
    MkArgs a{};
    for (int i = 0; i < 17; ++i) a.in[i] = (const float*)d_in[i];
    a.out = (float*)d_out; a.ws = (unsigned char*)d_ws;
    hipLaunchKernelGGL(mk_fwd, dim3(grid), dim3(512), LDS_BYTES, stream, a);
}
```

```cpp
#include <cstdio>
#include <cstdint>
#include <hip/hip_runtime.h>
namespace pg8 {
#define PG8_LAS __attribute__((address_space(3)))
typedef unsigned short bf16_t;
typedef short bf16x8 __attribute__((ext_vector_type(8)));
typedef float f32x4 __attribute__((ext_vector_type(4)));
typedef unsigned u32x4 __attribute__((ext_vector_type(4)));
constexpr int BM = 256, BK = 64, HALF = 128, HTB = HALF * BK * 2  , STAGE_BYTES = 8 * HTB, NXCD = 8, WGM = 4;

__host__ __device__ __forceinline__ int lds_byte(int r, int c) { const int st = (r >> 4) * 2 + (c >> 5), rr = r & 15, cc = c & 31, ob = rr * 64 + cc * 2; return st * 1024 + (ob ^ (((ob >> 9) & 1) << 5)); }
__host__ __device__ __forceinline__ void stage_rc(int b, int& R, int& C) { const int st = b / 1024, sb = b % 1024, swz = sb ^ (((sb >> 9) & 1) << 5); R = (st >> 1) * 16 + swz / 64; C = (st & 1) * 32 + (swz % 64) / 2; }
__host__ __device__ __forceinline__ int perm32(int rho) { const int n = rho >> 4, i = rho & 15; return 8 * (i >> 2) + 4 * n + (i & 3); }

struct Unit { int pm, pn; };
struct Gemm { const bf16_t* A; const bf16_t* Bt; int M, N, K, pad; };

struct StaticOrder {
    int nM, nN, nwg, G, c;
    __host__ __device__ void init(int M, int N, int G_, int c_) { nM = M / BM; nN = N / BM; nwg = nM * nN; G = G_; c = c_; }
    __host__ __device__ bool next(int i, Unit& u) const {
        const long L = (long)i * G + c; if (L >= nwg) return false;
        int wgid = (int)L; { const int q = nwg / NXCD, r = nwg % NXCD, xcd = wgid % NXCD, off = wgid / NXCD; wgid = (xcd < r ? xcd * (q + 1) : r * (q + 1) + (xcd - r) * q) + off; }
        const int nig = WGM * nN, gid = wgid / nig, fm = gid * WGM, gsz = (nM - fm) < WGM ? (nM - fm) : WGM;
        u.pm = fm + ((wgid % nig) % gsz); u.pn = (wgid % nig) / gsz; return true;
    }
    __device__ __forceinline__ void a_ready(const Unit&) const {}
    __device__ __forceinline__ void done(const Unit&) const {}
};
struct CountedOrder : StaticOrder {
    const unsigned* ready; unsigned need; unsigned* tmo;
    __device__ __forceinline__ void a_ready(const Unit& u) const {
        if (threadIdx.x < 64) {
            const unsigned long long t0 = __builtin_amdgcn_s_memrealtime(); unsigned polls = 0;
            while ((unsigned)__builtin_amdgcn_readfirstlane(__hip_atomic_load(ready + 64 * u.pm, __ATOMIC_RELAXED, __HIP_MEMORY_SCOPE_AGENT)) < need) {
                if ((++polls & 255u) == 0u && __builtin_amdgcn_readfirstlane(__hip_atomic_load(tmo, __ATOMIC_RELAXED, __HIP_MEMORY_SCOPE_AGENT)) != 0u) break;
                if (__builtin_amdgcn_s_memrealtime() - t0 > 2000000ull) {
                    if (threadIdx.x == 0) { unsigned expect = 0u; __hip_atomic_compare_exchange_strong(tmo + 1, &expect, 0x600u | (unsigned)(u.pm & 0xff), __ATOMIC_RELAXED, __ATOMIC_RELAXED, __HIP_MEMORY_SCOPE_AGENT); __hip_atomic_store(tmo, 1u, __ATOMIC_RELAXED, __HIP_MEMORY_SCOPE_AGENT); }
                    break; }
                __builtin_amdgcn_s_sleep(2); }
            __builtin_amdgcn_fence(__ATOMIC_ACQUIRE, "agent");
            asm volatile("s_waitcnt vmcnt(0)" ::: "memory");
        }
#if !defined(BROKEN_HOOK_NO_BARRIER)
        asm volatile("" ::: "memory"); __builtin_amdgcn_s_barrier(); asm volatile("" ::: "memory");
#endif
    }
};

typedef __bf16 cvt_pk_bf16_b2 __attribute__((ext_vector_type(2))); typedef float cvt_pk_bf16_f2 __attribute__((ext_vector_type(2)));
__device__ __forceinline__ unsigned cvt_pk_bf16(float lo, float hi) { const cvt_pk_bf16_f2 v = {lo, hi}; return __builtin_bit_cast(unsigned, __builtin_convertvector(v, cvt_pk_bf16_b2)); }
typedef float f32x2 __attribute__((ext_vector_type(2)));
__device__ __forceinline__ f32x2 gelu_pk(f32x2 v) {
    const f32x2 av = __builtin_elementwise_abs(v), d = av * 0.2316418882f + 1.0f;
    f32x2 t; t.x = __builtin_amdgcn_rcpf(d.x); t.y = __builtin_amdgcn_rcpf(d.y);
    f32x2 q = t * 0.5307027145f + (-0.7265760135f); q = q * t + 0.7107068705f; q = q * t + (-0.142248368f); q = q * t + 0.127414796f; q = q * t;
    const f32x2 s = (v * v) * (-0.72134752044f);
    f32x2 e; e.x = __builtin_amdgcn_exp2f(s.x); e.y = __builtin_amdgcn_exp2f(s.y);
    const f32x2 m = v * (q * e), r = v - m;
    f32x2 o; o.x = v.x < 0.f ? m.x : r.x; o.y = v.y < 0.f ? m.y : r.y; return o;
}

struct EpiF32 {
    static constexpr bool PERM = false, AFTER_DRAIN = false;
    float* C; int ldc; const float* bias;
    __device__ __forceinline__ void operator()(const f32x4 (&acc)[2][2][4][2], const Unit& u, int wr, int wc, int fr, int fq) const {
        const int row0 = u.pm * BM + wr * 64 + fr, col0 = u.pn * BM + wc * 32 + 4 * fq;
        f32x4 bv[2][2];
#pragma unroll
        for (int bj = 0; bj < 2; ++bj)
#pragma unroll
            for (int n = 0; n < 2; ++n) bv[bj][n] = bias ? *(const f32x4*)(bias + col0 + bj * HALF + n * 16) : (f32x4){0.f, 0.f, 0.f, 0.f};
#pragma unroll
        for (int ai = 0; ai < 2; ++ai)
#pragma unroll
            for (int m = 0; m < 4; ++m) { float* rowp = C + (size_t)(row0 + ai * HALF + m * 16) * ldc + col0;
#pragma unroll
                for (int bj = 0; bj < 2; ++bj)
#pragma unroll
                    for (int n = 0; n < 2; ++n) *(f32x4*)(rowp + bj * HALF + n * 16) = acc[ai][bj][m][n] + bv[bj][n]; }
    }
};
template <int ACT  > struct EpiBf16 {
    static constexpr bool PERM = true, AFTER_DRAIN = false;
    bf16_t* O; const float* bias; size_t split_stride; int ldc; int split_cols;
    __device__ __forceinline__ void operator()(const f32x4 (&acc)[2][2][4][2], const Unit& u, int wr, int wc, int fr, int fq) const {
        const int row0 = u.pm * BM + wr * 64 + fr; int colt = u.pn * BM; bf16_t* base = O;
        if (split_cols) { const int t = colt / split_cols; base += (size_t)t * split_stride; colt -= t * split_cols; }
        const int col0 = colt + wc * 32 + 8 * fq, bcol0 = u.pn * BM + wc * 32 + 8 * fq;
        f32x4 bv[2][2];
#pragma unroll
        for (int bj = 0; bj < 2; ++bj)
#pragma unroll
            for (int n = 0; n < 2; ++n) bv[bj][n] = bias ? *(const f32x4*)(bias + bcol0 + bj * HALF + 4 * n) : (f32x4){0.f, 0.f, 0.f, 0.f};
#pragma unroll
        for (int ai = 0; ai < 2; ++ai)
#pragma unroll
            for (int m = 0; m < 4; ++m) { bf16_t* rowp = base + (size_t)(row0 + ai * HALF + m * 16) * ldc + col0;
#pragma unroll
                for (int bj = 0; bj < 2; ++bj) { f32x4 v0 = acc[ai][bj][m][0] + bv[bj][0], v1 = acc[ai][bj][m][1] + bv[bj][1];
                    if (ACT == 1) { f32x2 a = gelu_pk((f32x2){v0[0], v0[1]}), b = gelu_pk((f32x2){v0[2], v0[3]}), c = gelu_pk((f32x2){v1[0], v1[1]}), d = gelu_pk((f32x2){v1[2], v1[3]});
                        v0 = (f32x4){a.x, a.y, b.x, b.y}; v1 = (f32x4){c.x, c.y, d.x, d.y}; }
                    if (ACT == 2) {
#pragma unroll
                        for (int j = 0; j < 4; ++j) { v0[j] = 0.5f * v0[j] * (1.0f + erff(v0[j] * 0.70710678f)); v1[j] = 0.5f * v1[j] * (1.0f + erff(v1[j] * 0.70710678f)); } }
                    u32x4 w; w.x = cvt_pk_bf16(v0[0], v0[1]); w.y = cvt_pk_bf16(v0[2], v0[3]); w.z = cvt_pk_bf16(v1[0], v1[1]); w.w = cvt_pk_bf16(v1[2], v1[3]);
                    *(u32x4*)(rowp + bj * HALF) = w; } }
    }
};
template <class E, class = void> struct ord_of { static constexpr bool v = false; };
template <class E> struct ord_of<E, decltype((void)E::ORD)> { static constexpr bool v = E::ORD; };
template <class E, class = void> struct ksplit_of { static constexpr int v = 1; };
template <class E> struct ksplit_of<E, decltype((void)E::KSPLIT)> { static constexpr int v = E::KSPLIT; };
template <class Epi, class Sched, bool STAMP = false>
__device__ __forceinline__ void gemm_phase(PG8_LAS unsigned char* lds, const Gemm g, const Sched& S, const Epi& E, unsigned long long* stamps, int wave_in = -1) {
    int tid_raw;
    if (wave_in >= 0) { int ones_ = -1; asm volatile("" : "+s"(ones_)); tid_raw = wave_in * 64 + (int)__builtin_amdgcn_mbcnt_hi((unsigned)ones_, __builtin_amdgcn_mbcnt_lo((unsigned)ones_, 0u)); } else tid_raw = threadIdx.x;
    asm volatile("" : "+v"(tid_raw));
    const int tid = tid_raw, wid = __builtin_amdgcn_readfirstlane(tid >> 6), lane = tid & 63, wr = wid >> 2, wc = wid & 3, fr = lane & 15, fq = lane >> 4;
    constexpr int KS = ksplit_of<Epi>::v;
    const int K = g.K, nt = K / BK / KS;
    const size_t khstep = (size_t)(K / KS) * 2;
    int ts_lo = 0, ts_hi = 0, nts = 0; const unsigned long long rt_entry = STAMP ? (unsigned long long)wall_clock64() : 0ull;
#define PG8_STAMP() do { if (STAMP && wid == 0 && nts < 64) { const unsigned long long _c = (unsigned long long)clock64(); \
        ts_lo = (lane == nts) ? (int)(unsigned)_c : ts_lo; ts_hi = (lane == nts) ? (int)(unsigned)(_c >> 32) : ts_hi; ++nts; } } while (0)
    PG8_STAMP();
    unsigned voffA[2], voffB[2];
#pragma unroll
    for (int i = 0; i < 2; ++i) { int R, C; stage_rc(tid * 16 + i * 8192, R, C); const int Rb = Epi::PERM ? ((R & ~31) + perm32(R & 31)) : R;
        voffA[i] = (unsigned)(R * K + C) * 2u; voffB[i] = (unsigned)(Rb * K + C) * 2u; }
    const size_t kstep = (size_t)(BK * 2);
    const size_t hstep = (size_t)HALF * K * 2;
    const size_t tstep = 2 * hstep;
    const unsigned ldsw = (unsigned)wid * 1024u;
    const int aoff = lds_byte(wr * 64 + fr, fq * 8), boff = lds_byte(wc * 32 + fr, fq * 8);
#define PG8_SA(b, h) (((b) * 2 + (h)) * HTB)
#define PG8_SB(b, h) ((4 + (b) * 2 + (h)) * HTB)
#define PG8_STAGE(bufoff, gbase, voff) do { _Pragma("unroll") for (int _i = 0; _i < 2; ++_i) \
        __builtin_amdgcn_global_load_lds((const unsigned*)((const char*)(gbase) + (voff)[_i]), (PG8_LAS unsigned*)(lds + (bufoff) + ldsw + _i * 8192), 16, 0, 0); } while (0)
#define PG8_LDA(dst, b, h) do { _Pragma("unroll") for (int m = 0; m < 4; ++m) _Pragma("unroll") for (int k = 0; k < 2; ++k) dst[m][k] = *(const PG8_LAS bf16x8*)(lds + PG8_SA(b, h) + aoff + m * 2048 + k * 1024); } while (0)
#define PG8_LDB(dst, b, h) do { _Pragma("unroll") for (int n = 0; n < 2; ++n) _Pragma("unroll") for (int k = 0; k < 2; ++k) dst[n][k] = *(const PG8_LAS bf16x8*)(lds + PG8_SB(b, h) + boff + n * 2048 + k * 1024); } while (0)
#define PG8_MMA(ai, bj, At, Bt) do { __builtin_amdgcn_s_setprio(1); _Pragma("unroll") for (int m = 0; m < 4; ++m) _Pragma("unroll") for (int n = 0; n < 2; ++n) _Pragma("unroll") for (int k = 0; k < 2; ++k) \
        acc[ai][bj][m][n] = __builtin_amdgcn_mfma_f32_16x16x32_bf16(Bt[n][k], At[m][k], acc[ai][bj][m][n], 0, 0, 0); __builtin_amdgcn_s_setprio(0); } while (0)
#define PG8_WAIT_V(n) asm volatile("s_waitcnt vmcnt(" #n ")" ::: "memory")
#define PG8_WAIT_L(n) asm volatile("s_waitcnt lgkmcnt(" #n ")" ::: "memory")
#define PG8_BAR __builtin_amdgcn_s_barrier()
#define PG8_SCHED __builtin_amdgcn_sched_barrier(0)
    Unit cur, nxt; int ui = 0;
    if (!S.next(0, cur)) return;
    int kh = 0;
    f32x4 acc[2][2][4][2];
#pragma unroll
    for (int a = 0; a < 2; ++a)
#pragma unroll
        for (int b = 0; b < 2; ++b)
#pragma unroll
            for (int m = 0; m < 4; ++m)
#pragma unroll
                for (int n = 0; n < 2; ++n) acc[a][b][m][n] = (f32x4){0.f, 0.f, 0.f, 0.f};
    bf16x8 At[4][2], B0[2][2], B1[2][2];
    const char* cA = (const char*)g.A + (size_t)cur.pm * tstep; const char* cB = (const char*)g.Bt + (size_t)cur.pn * tstep;
    S.a_ready(cur);
    PG8_STAGE(PG8_SB(0, 0), cB, voffB); PG8_STAGE(PG8_SA(0, 0), cA, voffA); PG8_STAGE(PG8_SB(0, 1), cB + hstep, voffB); PG8_STAGE(PG8_SA(0, 1), cA + hstep, voffA);
    if (wr == 1) PG8_BAR;
    PG8_WAIT_V(4); PG8_BAR;
    PG8_STAGE(PG8_SB(1, 0), cB + kstep, voffB); PG8_STAGE(PG8_SA(1, 0), cA + kstep, voffA); PG8_STAGE(PG8_SB(1, 1), cB + hstep + kstep, voffB);
    PG8_WAIT_V(6); PG8_BAR;
    PG8_STAMP();
    for (;;) {
        const int kh_n = (ui + 1) % KS; const bool has_next = S.next((ui + 1) / KS, nxt);
        const char* nA = has_next ? (const char*)g.A + (size_t)nxt.pm * tstep + (size_t)kh_n * khstep : cA; const char* nB = has_next ? (const char*)g.Bt + (size_t)nxt.pn * tstep + (size_t)kh_n * khstep : cB;
        for (int t = 0; t < nt; t += 2) {
            const bool last = (t == nt - 2);
            const char* a1 = cA + (size_t)(t + 1) * kstep;
            const char* a2 = last ? nA : cA + (size_t)(t + 2) * kstep; const char* b2 = last ? nB : cB + (size_t)(t + 2) * kstep;
            const char* a3 = a2 + kstep; const char* b3 = b2 + kstep;
            if (last && has_next) S.a_ready(nxt);
            PG8_LDB(B0, 0, 0); PG8_SCHED; PG8_LDA(At, 0, 0); PG8_STAGE(PG8_SA(1, 1), a1 + hstep, voffA);
            PG8_WAIT_L(8); PG8_BAR; PG8_WAIT_L(0); PG8_MMA(0, 0, At, B0); PG8_BAR; PG8_SCHED;
            PG8_LDB(B1, 0, 1); PG8_STAGE(PG8_SB(0, 0), b2, voffB);
            PG8_BAR; PG8_WAIT_L(0); PG8_MMA(0, 1, At, B1); PG8_BAR;
            PG8_LDA(At, 0, 1); PG8_STAGE(PG8_SA(0, 0), a2, voffA);
            PG8_BAR; PG8_WAIT_L(0); PG8_MMA(1, 0, At, B0); PG8_BAR; PG8_SCHED;
            PG8_STAGE(PG8_SB(0, 1), b2 + hstep, voffB);
            PG8_WAIT_V(6); PG8_BAR; PG8_MMA(1, 1, At, B1); PG8_BAR;
            PG8_LDB(B0, 1, 0); PG8_SCHED; PG8_LDA(At, 1, 0); PG8_STAGE(PG8_SA(0, 1), a2 + hstep, voffA);
            PG8_WAIT_L(8); PG8_BAR; PG8_WAIT_L(0); PG8_MMA(0, 0, At, B0); PG8_BAR; PG8_SCHED;
            PG8_LDB(B1, 1, 1); PG8_STAGE(PG8_SB(1, 0), b3, voffB);
            PG8_BAR; PG8_WAIT_L(0); PG8_MMA(0, 1, At, B1); PG8_BAR;
            PG8_LDA(At, 1, 1); PG8_STAGE(PG8_SA(1, 0), a3, voffA);
            PG8_BAR; PG8_WAIT_L(0); PG8_MMA(1, 0, At, B0); PG8_BAR; PG8_SCHED;
            PG8_STAGE(PG8_SB(1, 1), b3 + hstep, voffB);
            PG8_WAIT_V(6); PG8_BAR; PG8_MMA(1, 1, At, B1); PG8_BAR;
        }
        PG8_STAMP();
        bool keep_acc = false;
        if constexpr (KS > 1) { if (kh + 1 < KS) { E.mid(acc, cur, wr, wc, fr, fq, ui / KS); keep_acc = true; } else { E(acc, cur, wr, wc, fr, fq, ui / KS); S.done(cur); } }
        else if constexpr (ord_of<Epi>::v) { E(acc, cur, wr, wc, fr, fq, ui); S.done(cur); }
        else if constexpr (!Epi::AFTER_DRAIN) { E(acc, cur, wr, wc, fr, fq); S.done(cur); }
        PG8_STAMP();
        if (!has_next) break;
        if (!keep_acc) {
#pragma unroll
        for (int a = 0; a < 2; ++a)
#pragma unroll
            for (int b = 0; b < 2; ++b)
#pragma unroll
                for (int m = 0; m < 4; ++m)
#pragma unroll
                    for (int n = 0; n < 2; ++n) acc[a][b][m][n] = (f32x4){0.f, 0.f, 0.f, 0.f}; }
        cur = nxt; cA = nA; cB = nB; ++ui; kh = kh_n;
    }
    PG8_WAIT_V(0);
    if (wr == 0) PG8_BAR;
    PG8_BAR;
    if constexpr (Epi::AFTER_DRAIN) { E.fused(acc, cur, wr, wc, fr, fq, lds, wid, lane); S.done(cur); }
    PG8_STAMP();
    if (STAMP && wid == 0) { stamps[lane] = lane < nts ? (((unsigned long long)(unsigned)ts_hi << 32) | (unsigned)ts_lo) : 0ull;
        if (lane == 62) stamps[62] = rt_entry; if (lane == 63) stamps[63] = (unsigned long long)wall_clock64(); }
#undef PG8_STAMP
#undef PG8_SA
#undef PG8_SB
#undef PG8_STAGE
#undef PG8_LDA
#undef PG8_LDB
#undef PG8_MMA
#undef PG8_WAIT_V
#undef PG8_WAIT_L
#undef PG8_BAR
#undef PG8_SCHED
}
}

#define LAS __attribute__((address_space(3)))
typedef unsigned short bf16_t;
typedef float f32x4 __attribute__((ext_vector_type(4)));
typedef unsigned u32x4 __attribute__((ext_vector_type(4)));
typedef unsigned u32x2 __attribute__((ext_vector_type(2)));
typedef __bf16 bf16x2 __attribute__((ext_vector_type(2)));

constexpr int T = 16384, D = 2048, SEQ = 2048, NL = 4;
constexpr int DIN = 3904, DINP = 4096;
constexpr float EPS = 1e-6f;

__device__ __forceinline__ unsigned f2bf(float f) { unsigned u = __float_as_uint(f); return (u + 0x7fffu + ((u >> 16) & 1u)) >> 16; }
__device__ __forceinline__ unsigned pk2(float lo, float hi) { return f2bf(lo) | (f2bf(hi) << 16); }
__device__ __forceinline__ float bflo(unsigned w) { return __uint_as_float(w << 16); }
__device__ __forceinline__ float bfhi(unsigned w) { return __uint_as_float(w & 0xffff0000u); }
__device__ __forceinline__ float wave_sum(float v) {
#pragma unroll
    for (int o = 1; o < 64; o <<= 1) v += __shfl_xor(v, o);
    return v; }
__device__ __forceinline__ float wave_max(float v) {
#pragma unroll
    for (int o = 1; o < 64; o <<= 1) v = fmaxf(v, __shfl_xor(v, o));
    return v; }
__device__ __forceinline__ float dot2(unsigned a, unsigned b, float acc) { return __builtin_amdgcn_fdot2_f32_bf16(__builtin_bit_cast(bf16x2, a), __builtin_bit_cast(bf16x2, b), acc, false); }

__device__ __forceinline__ int src_col(int mode, int n) {
    if (mode == 0) {
        if (n < 768) return n;
        if (n < 3840) return n + 64;
        if (n < 3904) { const int i = n - 3840; return 768 + (i >> 1) + 32 * (i & 1); }
        return -1;
    } else if (mode == 1) {
        const int h = n / 192, i = n % 192; if (i < 128) return n; const int ii = i - 128; return h * 192 + 128 + (ii >> 1) + 32 * (ii & 1);
    } else if (mode == 2) {
        if (n < 1024) { const int h = n >> 7, d = n & 127; return h * 256 + d; }
        const int m = n - 1024, h = m >> 7, d = m & 127; return h * 256 + 128 + d;
    }
    return n;
}
__device__ __forceinline__ void rope8(f32x4& v0, f32x4& v1, const float* __restrict__ tabrow, int j0) {
    const f32x4 c = *(const f32x4*)(tabrow + j0), s = *(const f32x4*)(tabrow + 32 + j0);
    f32x4 a, b;
    a.x = v0.x * c.x - v0.y * s.x; a.y = v0.y * c.x + v0.x * s.x; a.z = v0.z * c.y - v0.w * s.y; a.w = v0.w * c.y + v0.z * s.y;
    b.x = v1.x * c.z - v1.y * s.z; b.y = v1.y * c.z + v1.x * s.z; b.z = v1.z * c.w - v1.w * s.w; b.w = v1.w * c.w + v1.z * s.w;
    v0 = a; v1 = b;
}
struct EpiIn {
    static constexpr bool PERM = true, AFTER_DRAIN = false;
    bf16_t *cq, *ckv, *nq, *nk, *nv, *kpe; const float* rope; float* lp;
    __device__ __forceinline__ void operator()(const pg8::f32x4 (&acc)[2][2][4][2], const pg8::Unit& u, int wr, int wc, int fr, int fq) const {
        const int pn = u.pn, row0 = u.pm * 256 + wr * 64 + fr, cit = wc * 32 + 8 * fq;
        if (pn == 15) {
            if (wc < 2) {
#pragma unroll
                for (int ai = 0; ai < 2; ++ai)
#pragma unroll
                    for (int m = 0; m < 4; ++m) { const int row = row0 + ai * 128 + m * 16;
                        f32x4 v0 = acc[ai][0][m][0], v1 = acc[ai][0][m][1];
                        rope8(v0, v1, rope + (size_t)(row & (SEQ - 1)) * 64, cit >> 1);
                        u32x4 w; w.x = pk2(v0.x, v0.y); w.y = pk2(v0.z, v0.w); w.z = pk2(v1.x, v1.y); w.w = pk2(v1.z, v1.w);
                        *(u32x4*)(kpe + (size_t)row * 64 + cit) = w; }
            }
            return;
        }
        bf16_t* base; int ld, c0; float sc = 1.f;
        if (pn < 2) { base = cq; ld = 512; c0 = pn * 256; }
        else if (pn == 2) { base = ckv; ld = 256; c0 = 0; }
        else if (pn < 7) { base = nq; ld = 1024; c0 = (pn - 3) * 256; sc = 0.125f; }
        else if (pn < 11) { base = nk; ld = 1024; c0 = (pn - 7) * 256; }
        else { base = nv; ld = 1024; c0 = (pn - 11) * 256; }
#pragma unroll
        for (int ai = 0; ai < 2; ++ai)
#pragma unroll
            for (int m = 0; m < 4; ++m) { const int row = row0 + ai * 128 + m * 16; bf16_t* rowp = base + (size_t)row * ld + c0 + cit; float ss = 0.f;
#pragma unroll
                for (int bj = 0; bj < 2; ++bj) { const f32x4 v0 = acc[ai][bj][m][0] * sc, v1 = acc[ai][bj][m][1] * sc;
                    u32x4 w; w.x = pk2(v0.x, v0.y); w.y = pk2(v0.z, v0.w); w.z = pk2(v1.x, v1.y); w.w = pk2(v1.z, v1.w);
                    *(u32x4*)(rowp + bj * 128) = w;
                    if (pn < 3) {
#pragma unroll
                        for (int q = 0; q < 4; ++q) { const float lo = __uint_as_float(w[q] << 16), hi = __uint_as_float(w[q] & 0xffff0000u); ss += lo * lo + hi * hi; } } }
                if (pn < 3) { ss += __shfl_xor(ss, 16); ss += __shfl_xor(ss, 32); if (fq == 0) lp[(size_t)row * 16 + pn * 4 + wc] = ss; } }
    }
};
__device__ __forceinline__ float lat_scale(const float* p, int n, float dim) { float t = 0.f; for (int i = 0; i < n; ++i) t += p[i]; return 1.0f / sqrtf(t / dim + EPS); }
struct EpiQ {
    static constexpr bool PERM = true, AFTER_DRAIN = false, ORD = true;
    bf16_t* Q; const float* rope; const LAS float* tab; const float* lp; float qscale; int pad;
    __device__ __forceinline__ void operator()(const pg8::f32x4 (&acc)[2][2][4][2], const pg8::Unit& u, int wr, int wc, int fr, int fq, int ord) const {
        int rl0 = wr * 64 + fr; asm volatile("" : "+v"(rl0)); const int row0 = u.pm * 256 + rl0;
#pragma unroll
        for (int bj = 0; bj < 2; ++bj) {
            const int col = u.pn * 256 + bj * 128 + wc * 32 + 8 * fq, i = col % 192; const bool rp = i >= 128; const int j0 = (i - 128) >> 1;
#pragma unroll
            for (int ai = 0; ai < 2; ++ai)
#pragma unroll
                for (int m = 0; m < 4; ++m) { const int row = row0 + ai * 128 + m * 16; const float qs = qscale * (ord < 20 ? tab[ord * 256 + rl0 + ai * 128 + m * 16] : lat_scale(lp + (size_t)row * 16, 8, 512.0f));
                    f32x4 v0 = acc[ai][bj][m][0] * qs, v1 = acc[ai][bj][m][1] * qs;
                    if (rp) rope8(v0, v1, rope + (size_t)(row & (SEQ - 1)) * 64, j0);
                    u32x4 w; w.x = pk2(v0.x, v0.y); w.y = pk2(v0.z, v0.w); w.z = pk2(v1.x, v1.y); w.w = pk2(v1.z, v1.w);
                    *(u32x4*)(Q + (size_t)row * 1536 + col) = w; } }
    }
};
struct EpiResid {
    static constexpr bool PERM = false, AFTER_DRAIN = false;
    float* X;
    __device__ __forceinline__ void operator()(const pg8::f32x4 (&acc)[2][2][4][2], const pg8::Unit& u, int wr, int wc, int fr, int fq) const {
        const int row0 = u.pm * 256 + wr * 64 + fr, col0 = u.pn * 256 + wc * 32 + 4 * fq;
#pragma unroll
        for (int ai = 0; ai < 2; ++ai)
#pragma unroll
            for (int m = 0; m < 4; ++m) { float* rowp = X + (size_t)(row0 + ai * 128 + m * 16) * D + col0;
#pragma unroll
                for (int bj = 0; bj < 2; ++bj)
#pragma unroll
                    for (int n = 0; n < 2; ++n) { f32x4* p = (f32x4*)(rowp + bj * 128 + n * 16); *p = *p + acc[ai][bj][m][n]; } }
    }
};
#define XB_TMO      128
#define XB_XCNT(j)  (256  + 64 * (j))
#define XB_XSUB(j)  (1280 + 64 * (j))
#define XB_XGEN(j)  (2304 + 64 * (j))
#define XB_TOP      3328
#define XB_TOPGEN   3392
#define XCD_BAR_WORDS 3456
#define XB_SPIN_CAP (1u << 22)
#define LAS __attribute__((address_space(3)))

__device__ __forceinline__ unsigned xb_ld(unsigned* p)              { return __hip_atomic_load(p, __ATOMIC_RELAXED, __HIP_MEMORY_SCOPE_AGENT); }
__device__ __forceinline__ unsigned xb_add(unsigned* p, unsigned v) { return __hip_atomic_fetch_add(p, v, __ATOMIC_RELAXED, __HIP_MEMORY_SCOPE_AGENT); }
__device__ __forceinline__ unsigned xb_xcc_id() { return (unsigned)__builtin_amdgcn_s_getreg((3 << 11) | 20) & 0xFu; }
#define XB_SPIN(cond, bar) do { unsigned _sp = 0; while (cond) { \
    if ((++_sp & 255u) == 0u) { if (xb_ld(&(bar)[XB_TMO])) break; if (_sp > XB_SPIN_CAP) { atomicAdd(&(bar)[XB_TMO], 1u); break; } } } } while (0)

struct XcdBarrier {
    unsigned* bar; unsigned x;
    volatile LAS unsigned* st;
};

__device__ __forceinline__ XcdBarrier xcd_barrier_post(unsigned* bar, volatile LAS unsigned* st) {
    XcdBarrier b; b.bar = bar; b.x = xb_xcc_id(); b.st = st;
    if (threadIdx.x == 0) (void)xb_add(&bar[XB_XCNT(b.x)], 1u);
    return b;
}
__device__ __forceinline__ void xcd_barrier_complete(unsigned* bar, unsigned x, unsigned& nloc, unsigned& nx) {
    const unsigned G = gridDim.x * gridDim.y * gridDim.z;
    unsigned sum, cnt, mine, sp = 0u;
    for (;;) {
        sum = 0u; cnt = 0u; mine = 0u;
#pragma unroll
        for (unsigned j = 0; j < 16; ++j) { const unsigned c = xb_ld(&bar[XB_XCNT(j)]); sum += c; cnt += (c > 0u) ? 1u : 0u; mine = (j == x) ? c : mine; }
        if (sum == G) break;
        __builtin_amdgcn_s_sleep(1);
        if ((++sp & 255u) == 0u) { if (xb_ld(&bar[XB_TMO])) break; if (sp > XB_SPIN_CAP) { atomicAdd(&bar[XB_TMO], 1u); break; } }
    }
    nloc = mine > 0u ? mine : 1u; nx = cnt > 0u ? cnt : 1u;
}

__device__ __forceinline__ void xcd_barrier(const XcdBarrier& b, bool is_t0) {
    asm volatile("s_waitcnt vmcnt(0)" ::: "memory");
    __syncthreads();
    if (is_t0) {
        unsigned* bar = b.bar; unsigned bx = b.x; asm volatile("" : "+s"(bx));
        __builtin_amdgcn_s_waitcnt(0);
        unsigned nloc = b.st[0], nx = b.st[1];
        if (nloc == 0u) { xcd_barrier_complete(bar, bx, nloc, nx); b.st[0] = nloc; b.st[1] = nx; }
        const unsigned old = xb_add(&bar[XB_XSUB(bx)], 1u);
        const unsigned gen = old / nloc;
        if (old + 1u == (gen + 1u) * nloc) {
            __builtin_amdgcn_fence(__ATOMIC_RELEASE, "agent");
            asm volatile("s_waitcnt vmcnt(0)" ::: "memory");
            const unsigned og = xb_add(&bar[XB_TOP], 1u);
            const unsigned tg = og / nx;
            if (og + 1u == (tg + 1u) * nx) xb_add(&bar[XB_TOPGEN], 1u);
            else XB_SPIN(xb_ld(&bar[XB_TOPGEN]) == tg, bar);
            __builtin_amdgcn_fence(__ATOMIC_ACQUIRE, "agent");
            xb_add(&bar[XB_XGEN(bx)], 1u);
            asm volatile("s_waitcnt vmcnt(0)" ::: "memory");
        } else {
            XB_SPIN(xb_ld(&bar[XB_XGEN(bx)]) == gen, bar);
            __builtin_amdgcn_fence(__ATOMIC_ACQUIRE, "agent");
            asm volatile("s_waitcnt vmcnt(0)" ::: "memory");
        }
    }
    __syncthreads();
}

namespace mla {
using bf16x8 = __attribute__((ext_vector_type(8))) short;
using s16x4  = __attribute__((ext_vector_type(4))) short;
using f32x16 = __attribute__((ext_vector_type(16))) float;
using u32x4v = __attribute__((ext_vector_type(4))) unsigned;
constexpr int NW = 8, QBLK = 32, KVBLK = 64, DQK = 192, DV = 128;
constexpr float THR = 8.f;
constexpr int SHM_V = KVBLK * DV * 2, SHM_K = KVBLK * DQK * 2, SHM_ATTN = 3 * SHM_V + 2 * SHM_K + NW * 64 * 4;
#define MLA_KSWZ(row, colB) ((row) * 384 + ((colB) ^ (((row) & 7) << 4)))
#define MLA_SBAR() __builtin_amdgcn_sched_barrier(0)
__device__ __forceinline__ int crow(int r, int hi) { return (r & 3) + 8 * (r >> 2) + 4 * hi; }
__device__ __forceinline__ void half32_rowsum_store(const float (&v)[16], int lane, float* __restrict__ dst  , int stride) {
  const bool b4 = lane & 16, b3 = lane & 8, b2 = lane & 4, b1 = lane & 2; const int hi = lane >> 5;
  float w[8], x[4], y[2];
#pragma unroll
  for (int i = 0; i < 8; ++i) { const float send = b4 ? v[i] : v[i + 8], keep = b4 ? v[i + 8] : v[i]; w[i] = keep + __shfl_xor(send, 16); }
#pragma unroll
  for (int i = 0; i < 4; ++i) { const float send = b3 ? w[i] : w[i + 4], keep = b3 ? w[i + 4] : w[i]; x[i] = keep + __shfl_xor(send, 8); }
#pragma unroll
  for (int i = 0; i < 2; ++i) { const float send = b2 ? x[i] : x[i + 2], keep = b2 ? x[i + 2] : x[i]; y[i] = keep + __shfl_xor(send, 4); }
  float z; { const float send = b1 ? y[0] : y[1], keep = b1 ? y[1] : y[0]; z = keep + __shfl_xor(send, 2); }
  z += __shfl_xor(z, 1);
  const int r = (b4 ? 8 : 0) + (b3 ? 4 : 0) + (b2 ? 2 : 0) + (b1 ? 1 : 0);
  if (!(lane & 1)) dst[crow(r, hi) * stride] = z;
}
typedef __bf16 cvtpk_b2 __attribute__((ext_vector_type(2))); typedef float cvtpk_f2 __attribute__((ext_vector_type(2)));
__device__ __forceinline__ unsigned cvtpk(float lo, float hi) { const cvtpk_f2 v = {lo, hi}; return __builtin_bit_cast(unsigned, __builtin_convertvector(v, cvtpk_b2)); }
__device__ __forceinline__ void partialSM(f32x16& p0, f32x16& p1, float& m_reg, float& mn, float& alpha) {
  constexpr float C = 1.4426950408889634f;
  float pmax = p0[0];
#pragma unroll
  for (int r = 1; r < 16; ++r) pmax = fmaxf(pmax, p0[r]);
#pragma unroll
  for (int r = 0; r < 16; ++r) pmax = fmaxf(pmax, p1[r]);
  { auto rr = __builtin_amdgcn_permlane32_swap(__float_as_uint(pmax), __float_as_uint(pmax), false, false);
    pmax = fmaxf(__uint_as_float(rr[0]), __uint_as_float(rr[1])); }
  if (__builtin_expect(__all(pmax - m_reg <= THR), 1)) { mn = m_reg; alpha = 1.f; }
  else { mn = fmaxf(m_reg, pmax); alpha = __builtin_amdgcn_exp2f((m_reg - mn) * C); m_reg = mn; }
  float mnC = -mn * C;
#pragma unroll
  for (int r = 0; r < 16; ++r) p0[r] = fmaf(p0[r], C, mnC);
#pragma unroll
  for (int r = 0; r < 16; ++r) p1[r] = fmaf(p1[r], C, mnC);
#pragma unroll
  for (int r = 0; r < 16; ++r) p0[r] = __builtin_amdgcn_exp2f(p0[r]);
}
__device__ __forceinline__ void finishSM(f32x16& p0, f32x16& p1, float alpha, float& l_reg, bf16x8& pa0, bf16x8& pa1, bf16x8& pa2, bf16x8& pa3) {
#pragma unroll
  for (int r = 0; r < 16; ++r) p1[r] = __builtin_amdgcn_exp2f(p1[r]);
  float ps = 0;
#pragma unroll
  for (int r = 0; r < 16; ++r) ps += p0[r];
#pragma unroll
  for (int r = 0; r < 16; ++r) ps += p1[r];
  { auto rr = __builtin_amdgcn_permlane32_swap(__float_as_uint(ps), __float_as_uint(ps), false, false);
    ps = __uint_as_float(rr[0]) + __uint_as_float(rr[1]); }
  l_reg = l_reg * alpha + ps;
#define MLA_PK4(P, BASE, OUT) do { unsigned a0 = cvtpk(P[BASE + 0], P[BASE + 1]), a1 = cvtpk(P[BASE + 2], P[BASE + 3]);   \
    unsigned b0 = cvtpk(P[BASE + 4], P[BASE + 5]), b1 = cvtpk(P[BASE + 6], P[BASE + 7]);                              \
    auto r0 = __builtin_amdgcn_permlane32_swap(a0, b0, false, false); auto r1 = __builtin_amdgcn_permlane32_swap(a1, b1, false, false); \
    u32x4v w = {r0[0], r1[0], r0[1], r1[1]}; OUT = *reinterpret_cast<bf16x8*>(&w); } while (0)
  MLA_PK4(p0, 0, pa0); MLA_PK4(p0, 8, pa1); MLA_PK4(p1, 0, pa2); MLA_PK4(p1, 8, pa3);
#undef MLA_PK4
}
__device__ __forceinline__ void qkt(f32x16& p0, f32x16& p1, const LAS char* Ks, const bf16x8 (&qr)[12], int r32, int hi) {
  p0 = f32x16{}; p1 = f32x16{};
#pragma unroll
  for (int d0 = 0; d0 < 12; ++d0) { const int cb = (d0 * 16 + hi * 8) * 2;
    const bf16x8 b0 = *reinterpret_cast<const LAS bf16x8*>(Ks + MLA_KSWZ(r32, cb));
    const bf16x8 b1 = *reinterpret_cast<const LAS bf16x8*>(Ks + MLA_KSWZ(32 + r32, cb));
    p0 = __builtin_amdgcn_mfma_f32_32x32x16_bf16(b0, qr[d0], p0, 0, 0, 0);
    p1 = __builtin_amdgcn_mfma_f32_32x32x16_bf16(b1, qr[d0], p1, 0, 0, 0); }
}
__device__ __forceinline__ int v_st(int k, int c) { const int kk = (k & ~0xC) | ((k & 4) << 1) | ((k & 8) >> 1); return ((kk >> 3) * 4 + (c >> 5)) * 512 + ((kk & 7) * 32 + (c & 31)) * 2; }
__device__ __forceinline__ int v_rd_base(int lane) { return ((lane & 3) << 3) | (((lane >> 2) & 3) << 6) | (((lane >> 4) & 1) << 5) | (((lane >> 5) & 1) << 8); }
constexpr int v_rd_off(int d0, int ks, int half) { return d0 * 512 + ks * 4096 + half * 2048; }
template <int OFF> __device__ __forceinline__ s16x4 tr_read(int vb) {
  s16x4 r; asm volatile("ds_read_b64_tr_b16 %0, %1 offset:%2" : "=&v"(r) : "v"(vb), "i"(OFF) : "memory"); return r;
}
template <int D0> __device__ __forceinline__ void pv_one(f32x16& od, int vb, bf16x8 pa0, bf16x8 pa1, bf16x8 pa2, bf16x8 pa3) {
  const s16x4 l0 = tr_read<v_rd_off(D0, 0, 0)>(vb), h0 = tr_read<v_rd_off(D0, 0, 1)>(vb), l1 = tr_read<v_rd_off(D0, 1, 0)>(vb), h1 = tr_read<v_rd_off(D0, 1, 1)>(vb);
  const s16x4 l2 = tr_read<v_rd_off(D0, 2, 0)>(vb), h2 = tr_read<v_rd_off(D0, 2, 1)>(vb), l3 = tr_read<v_rd_off(D0, 3, 0)>(vb), h3 = tr_read<v_rd_off(D0, 3, 1)>(vb);
  asm volatile("s_waitcnt lgkmcnt(0)" ::: "memory"); MLA_SBAR();
#define MLA_PK(L, H) (bf16x8){L[0], L[1], L[2], L[3], H[0], H[1], H[2], H[3]}
  od = __builtin_amdgcn_mfma_f32_32x32x16_bf16(pa0, MLA_PK(l0, h0), od, 0, 0, 0);
  od = __builtin_amdgcn_mfma_f32_32x32x16_bf16(pa1, MLA_PK(l1, h1), od, 0, 0, 0);
  od = __builtin_amdgcn_mfma_f32_32x32x16_bf16(pa2, MLA_PK(l2, h2), od, 0, 0, 0);
  od = __builtin_amdgcn_mfma_f32_32x32x16_bf16(pa3, MLA_PK(l3, h3), od, 0, 0, 0);
#undef MLA_PK
}
__device__ __forceinline__ void pv_d0(f32x16 (&o)[4], int vb, bf16x8 pa0, bf16x8 pa1, bf16x8 pa2, bf16x8 pa3) {
  pv_one<0>(o[0], vb, pa0, pa1, pa2, pa3); pv_one<1>(o[1], vb, pa0, pa1, pa2, pa3); pv_one<2>(o[2], vb, pa0, pa1, pa2, pa3); pv_one<3>(o[3], vb, pa0, pa1, pa2, pa3);
}
__device__ __forceinline__ void attn_unit(int tid, const bf16_t* __restrict__ Qb, const bf16_t* __restrict__ Kh, const bf16_t* __restrict__ Vh, const bf16_t* __restrict__ Kp,
                                          bf16_t* __restrict__ Ob, float* __restrict__ ssq, LAS char* lds) {
  constexpr int LDQ = 1536, LDK = 1024, LDP = 64, LDO = 2048, NT = SEQ / KVBLK;
  const int wid = tid >> 6, lane = tid & 63, r32 = lane & 31, hi = lane >> 5;
  LAS char* V_lds = lds; LAS char* K_lds = lds + 3 * SHM_V;
  LAS float* wsf = (LAS float*)(lds + 3 * SHM_V + 2 * SHM_K) + wid * 64; LAS float* li_l = wsf; LAS float* al_l = wsf + 32;
  float m_reg = -1e30f, l_reg = 0; f32x16 o[4] = {}; bf16x8 qr[12];
  const bf16_t* Qw = Qb + (long)(wid * QBLK + r32) * LDQ + hi * 8;
#pragma unroll
  for (int d0 = 0; d0 < 12; ++d0) qr[d0] = *reinterpret_cast<const bf16x8*>(Qw + d0 * 16);
  const int sr = tid >> 4, sc = (tid & 15) * 8, vst0 = v_st(sr, sc), vst1 = v_st(32 + sr, sc);
  const int rr = tid >> 3, rc = (tid & 7) * 8;
  const int vb0 = (int)(uintptr_t)V_lds + v_rd_base(lane);
  bf16x8 s_vs0, s_vs1, s_ks0, s_ks1, s_kr;
#define MLA_SLOAD(k0) do { s_vs0 = *reinterpret_cast<const bf16x8*>(&Vh[(long)((k0) + sr) * LDK + sc]); s_vs1 = *reinterpret_cast<const bf16x8*>(&Vh[(long)((k0) + 32 + sr) * LDK + sc]); \
    s_ks0 = *reinterpret_cast<const bf16x8*>(&Kh[(long)((k0) + sr) * LDK + sc]); s_ks1 = *reinterpret_cast<const bf16x8*>(&Kh[(long)((k0) + 32 + sr) * LDK + sc]); \
    s_kr = *reinterpret_cast<const bf16x8*>(&Kp[(long)((k0) + rr) * LDP + rc]); } while (0)
#define MLA_SWRITE(kb, vbuf) do { *(LAS bf16x8*)(V_lds + (vbuf) * SHM_V + vst0) = s_vs0; *(LAS bf16x8*)(V_lds + (vbuf) * SHM_V + vst1) = s_vs1; const int kc = sc * 2; \
    *(LAS bf16x8*)(K_lds + (kb) * SHM_K + MLA_KSWZ(sr, kc)) = s_ks0; *(LAS bf16x8*)(K_lds + (kb) * SHM_K + MLA_KSWZ(32 + sr, kc)) = s_ks1; \
    *(LAS bf16x8*)(K_lds + (kb) * SHM_K + MLA_KSWZ(rr, 256 + rc * 2)) = s_kr; } while (0)
#define MLA_SWAIT() asm volatile("s_waitcnt vmcnt(0)" ::: "memory")
#define MLA_RESC(a) do { if (__any((a) < 1.f)) { if (hi == 0) al_l[r32] = (a); asm volatile("s_waitcnt lgkmcnt(0)" ::: "memory"); \
    _Pragma("unroll") for (int d = 0; d < 4; ++d) _Pragma("unroll") for (int r = 0; r < 16; ++r) o[d][r] *= al_l[crow(r, hi)]; } } while (0)
  f32x16 p0, p1; float mn, al; bf16x8 pa0, pa1, pa2, pa3;
  const bool grpB = wid >= 4;
  MLA_SLOAD(0); MLA_SWAIT(); MLA_SWRITE(0, 0); MLA_SLOAD(KVBLK); __syncthreads();
  int vcur = 0;
  for (int j = 0; j < NT; ++j) {
    const int kbuf = j & 1, vnext = vcur == 2 ? 0 : vcur + 1, vprev = vcur == 0 ? 2 : vcur - 1;
    if (j + 1 < NT) { MLA_SWAIT(); MLA_SWRITE(kbuf ^ 1, vnext); }
    if (j + 2 < NT) MLA_SLOAD((j + 2) * KVBLK);
    MLA_SBAR();
    if (!grpB) {
      qkt(p0, p1, K_lds + kbuf * SHM_K, qr, r32, hi);
      partialSM(p0, p1, m_reg, mn, al);
      MLA_RESC(al);
      finishSM(p0, p1, al, l_reg, pa0, pa1, pa2, pa3); MLA_SBAR();
      pv_d0(o, vb0 + vcur * SHM_V, pa0, pa1, pa2, pa3);
    } else {
      if (j > 0) pv_d0(o, vb0 + vprev * SHM_V, pa0, pa1, pa2, pa3);
      MLA_SBAR(); qkt(p0, p1, K_lds + kbuf * SHM_K, qr, r32, hi);
      partialSM(p0, p1, m_reg, mn, al);
      MLA_RESC(al);
      finishSM(p0, p1, al, l_reg, pa0, pa1, pa2, pa3);
    }
    __syncthreads();
    vcur = vnext;
  }
  if (grpB) pv_d0(o, vb0 + (vcur == 0 ? 2 : vcur - 1) * SHM_V, pa0, pa1, pa2, pa3);
  if (hi == 0) li_l[r32] = l_reg; asm volatile("s_waitcnt lgkmcnt(0)" ::: "memory");
  float rli[16];
#pragma unroll
  for (int r = 0; r < 16; ++r) rli[r] = __builtin_amdgcn_rcpf(li_l[crow(r, hi)]);
  bf16_t* Ow = Ob + (long)(wid * QBLK) * LDO;
  float ssr[16];
#pragma unroll
  for (int r = 0; r < 16; ++r) { const int orow = crow(r, hi); float sq = 0.f;
#pragma unroll
    for (int d0 = 0; d0 < 4; ++d0) { const unsigned bv = f2bf(o[d0][r] * rli[r]); Ow[(long)orow * LDO + d0 * 32 + r32] = (bf16_t)bv; const float fv = __uint_as_float(bv << 16); sq += fv * fv; }
    ssr[r] = sq; }
  half32_rowsum_store(ssr, lane, ssq + wid * QBLK * 8, 8);
#undef MLA_SLOAD
#undef MLA_SWRITE
#undef MLA_SWAIT
#undef MLA_RESC
}
}

namespace natm {
using mla::bf16x8; using mla::f32x16; using mla::crow;
constexpr int SHM_T = 64 * 128 * 2;
constexpr int OFF_V = 0, OFF_K = 2 * SHM_T, OFF_RP = 4 * SHM_T, OFF_WS = OFF_RP + 30720, LDS_NAT = OFF_WS + 8 * 256;
#define NAT_KSWZ(row, colB) ((row) * 256 + ((colB) ^ (((row) & 7) << 4)))
template <int HH> __device__ __forceinline__ void qkt(f32x16& p0, f32x16& p1, const LAS char* Ks, const bf16x8 (&qr)[2][4], int r32, int hi) {
  p0 = f32x16{}; p1 = f32x16{};
#pragma unroll
  for (int d0 = 0; d0 < 4; ++d0) { const int cb = (HH * 64 + d0 * 16 + hi * 8) * 2;
    const bf16x8 b0 = *reinterpret_cast<const LAS bf16x8*>(Ks + NAT_KSWZ(r32, cb));
    const bf16x8 b1 = *reinterpret_cast<const LAS bf16x8*>(Ks + NAT_KSWZ(32 + r32, cb));
    p0 = __builtin_amdgcn_mfma_f32_32x32x16_bf16(b0, qr[HH][d0], p0, 0, 0, 0);
    p1 = __builtin_amdgcn_mfma_f32_32x32x16_bf16(b1, qr[HH][d0], p1, 0, 0, 0); }
}
template <int PAR> __device__ __forceinline__ constexpr bool act0(int r) { return PAR == 0 || r >= 12; }
template <int PAR> __device__ __forceinline__ constexpr bool act1(int r) { return PAR == 1 || r < 4; }
template <int PAR> __device__ __forceinline__ void bias_mask(f32x16& p0, f32x16& p1, const LAS float* bp, int cs, int hi) {
#pragma unroll
  for (int r = 0; r < 16; ++r) { const int kc0 = (r & 3) + 8 * (r >> 2);
    const int kc = kc0 + 4 * hi;
    if (act0<PAR>(r)) p0[r] = ((unsigned)(kc - cs) < 16u) ? p0[r] + bp[kc] : -1e30f;
    if (act1<PAR>(r)) p1[r] = ((unsigned)(kc + 32 - cs) < 16u) ? p1[r] + bp[kc + 32] : -1e30f; }
}
template <int PAR> __device__ __forceinline__ void partialSM(f32x16& p0, f32x16& p1, float& m_reg, float& mn, float& alpha) {
  constexpr float C = 1.4426950408889634f;
  float pmax = -1e30f;
#pragma unroll
  for (int r = 0; r < 16; ++r) if (act0<PAR>(r)) pmax = fmaxf(pmax, p0[r]);
#pragma unroll
  for (int r = 0; r < 16; ++r) if (act1<PAR>(r)) pmax = fmaxf(pmax, p1[r]);
  { auto rr = __builtin_amdgcn_permlane32_swap(__float_as_uint(pmax), __float_as_uint(pmax), false, false);
    pmax = fmaxf(__uint_as_float(rr[0]), __uint_as_float(rr[1])); }
  if (__builtin_expect(__all(pmax - m_reg <= mla::THR), 1)) { mn = m_reg; alpha = 1.f; }
  else { mn = fmaxf(m_reg, pmax); alpha = __builtin_amdgcn_exp2f((m_reg - mn) * C); m_reg = mn; }
  const float mnC = -mn * C;
#pragma unroll
  for (int r = 0; r < 16; ++r) p0[r] = act0<PAR>(r) ? __builtin_amdgcn_exp2f(fmaf(p0[r], C, mnC)) : 0.f;
#pragma unroll
  for (int r = 0; r < 16; ++r) p1[r] = act1<PAR>(r) ? __builtin_amdgcn_exp2f(fmaf(p1[r], C, mnC)) : 0.f;
}
template <int PAR> __device__ __forceinline__ void finishSM(f32x16& p0, f32x16& p1, float alpha, float& l_reg, bf16x8& pa0, bf16x8& pa1, bf16x8& pa2, bf16x8& pa3) {
  float ps = 0;
#pragma unroll
  for (int r = 0; r < 16; ++r) if (act0<PAR>(r)) ps += p0[r];
#pragma unroll
  for (int r = 0; r < 16; ++r) if (act1<PAR>(r)) ps += p1[r];
  { auto rr = __builtin_amdgcn_permlane32_swap(__float_as_uint(ps), __float_as_uint(ps), false, false);
    ps = __uint_as_float(rr[0]) + __uint_as_float(rr[1]); }
  l_reg = l_reg * alpha + ps;
#define NAT_CV(P, A, i) ((A(i) || A(i + 1)) ? mla::cvtpk(P[i], P[i + 1]) : 0u)
#define NAT_PK4(P, A, BASE, OUT) do { const unsigned a0 = NAT_CV(P, A, BASE + 0), a1 = NAT_CV(P, A, BASE + 2), b0 = NAT_CV(P, A, BASE + 4), b1 = NAT_CV(P, A, BASE + 6); \
    if (A(BASE) || A(BASE + 7)) { auto r0 = __builtin_amdgcn_permlane32_swap(a0, b0, false, false); auto r1 = __builtin_amdgcn_permlane32_swap(a1, b1, false, false); \
      mla::u32x4v w = {r0[0], r1[0], r0[1], r1[1]}; OUT = *reinterpret_cast<bf16x8*>(&w); } else { OUT = bf16x8{0, 0, 0, 0, 0, 0, 0, 0}; } } while (0)
  NAT_PK4(p0, act0<PAR>, 0, pa0); NAT_PK4(p0, act0<PAR>, 8, pa1); NAT_PK4(p1, act1<PAR>, 0, pa2); NAT_PK4(p1, act1<PAR>, 8, pa3);
#undef NAT_PK4
#undef NAT_CV
}
template <int HH, int PAR> __device__ __forceinline__ void head_step(f32x16 (&o)[2][2], float (&m_reg)[2], float (&l_reg)[2], const LAS char* Kt, int vb, const bf16x8 (&qr)[2][4],
                                                            const LAS float* bp, int cs, int r32, int hi, LAS float* al_l) {
  f32x16 p0, p1; float mn, al; bf16x8 pa0, pa1, pa2, pa3;
  qkt<HH>(p0, p1, Kt, qr, r32, hi);
  bias_mask<PAR>(p0, p1, bp, cs, hi);
  partialSM<PAR>(p0, p1, m_reg[HH], mn, al);
  if (__any(al < 1.f)) { if (hi == 0) al_l[r32] = al; asm volatile("s_waitcnt lgkmcnt(0)" ::: "memory");
#pragma unroll
    for (int d = 0; d < 2; ++d)
#pragma unroll
      for (int r = 0; r < 16; ++r) o[HH][d][r] *= al_l[crow(r, hi)]; }
  finishSM<PAR>(p0, p1, al, l_reg[HH], pa0, pa1, pa2, pa3); __builtin_amdgcn_sched_barrier(0);
  mla::pv_one<2 * HH>(o[HH][0], vb, pa0, pa1, pa2, pa3); mla::pv_one<2 * HH + 1>(o[HH][1], vb, pa0, pa1, pa2, pa3);
}
__device__ __forceinline__ void nat_unit(int unit, int tid, const bf16_t* __restrict__ nq, const bf16_t* __restrict__ nk, const bf16_t* __restrict__ nv, bf16_t* __restrict__ out, float* __restrict__ ssq, LAS char* lds) {
  const int rg = unit & 7, hp = (unit >> 3) & 7, b = unit >> 6;
  const int wid = tid >> 6, lane = tid & 63, r32 = lane & 31, hi = lane >> 5;
  const int rw = 4 * rg + (wid >> 1), c = 32 * (wid & 1) + r32, cs = min(max(c - 8, 0), 48), rsw = min(max(rw - 4, 0), 24);
  const int kfirst = min(max(4 * rg - 4, 0), 24), klast = min(max(4 * rg + 3 - 4, 0), 24) + 7;
  LAS char* V_lds = lds + OFF_V; LAS char* K_lds = lds + OFF_K; const LAS float* rp = (const LAS float*)(lds + OFF_RP);
  LAS float* wsf = (LAS float*)(lds + OFF_WS) + wid * 64; LAS float* li_l = wsf; LAS float* al_l = wsf + 32;
  const size_t tb = (size_t)b * 2048;
  bf16x8 qr[2][4];
  { const bf16_t* Qw = nq + (tb + rw * 64 + c) * 1024 + hp * 128 + hi * 8;
#pragma unroll
    for (int hh = 0; hh < 2; ++hh)
#pragma unroll
      for (int d0 = 0; d0 < 4; ++d0) qr[hh][d0] = *reinterpret_cast<const bf16x8*>(Qw + hh * 64 + d0 * 16); }
  float m_reg[2] = {-1e30f, -1e30f}, l_reg[2] = {0.f, 0.f}; f32x16 o[2][2] = {};
  const int sr = tid >> 4, sc = (tid & 15) * 8, vst0 = mla::v_st(sr, sc), vst1 = mla::v_st(32 + sr, sc);
  const int vb0 = (int)(uintptr_t)V_lds + mla::v_rd_base(lane);
  const bf16_t* Kh = nk + tb * 1024 + hp * 128; const bf16_t* Vh = nv + tb * 1024 + hp * 128;
  bf16x8 s_vs0, s_vs1, s_ks0, s_ks1;
#define NATM_SLOAD(kr) do { const long k0_ = (long)(kr) * 64; s_vs0 = *reinterpret_cast<const bf16x8*>(&Vh[(k0_ + sr) * 1024 + sc]); s_vs1 = *reinterpret_cast<const bf16x8*>(&Vh[(k0_ + 32 + sr) * 1024 + sc]); \
    s_ks0 = *reinterpret_cast<const bf16x8*>(&Kh[(k0_ + sr) * 1024 + sc]); s_ks1 = *reinterpret_cast<const bf16x8*>(&Kh[(k0_ + 32 + sr) * 1024 + sc]); } while (0)
#define NATM_SWRITE(bf) do { *(LAS bf16x8*)(V_lds + (bf) * SHM_T + vst0) = s_vs0; *(LAS bf16x8*)(V_lds + (bf) * SHM_T + vst1) = s_vs1; const int kc_ = sc * 2; \
    *(LAS bf16x8*)(K_lds + (bf) * SHM_T + NAT_KSWZ(sr, kc_)) = s_ks0; *(LAS bf16x8*)(K_lds + (bf) * SHM_T + NAT_KSWZ(32 + sr, kc_)) = s_ks1; } while (0)
  NATM_SLOAD(kfirst); asm volatile("s_waitcnt vmcnt(0)" ::: "memory"); NATM_SWRITE(0);
  if (kfirst < klast) NATM_SLOAD(kfirst + 1);
  __syncthreads();
  for (int kr = kfirst; kr <= klast; ++kr) {
    const int buf = (kr - kfirst) & 1;
    if (kr < klast) { asm volatile("s_waitcnt vmcnt(0)" ::: "memory"); NATM_SWRITE(buf ^ 1); }
    if (kr + 1 < klast) NATM_SLOAD(kr + 2);
    __builtin_amdgcn_sched_barrier(0);
    if (kr >= rsw && kr < rsw + 8) {
      const LAS float* bp0 = rp + (2 * hp) * 465 + (kr - rw + 7) * 31 + (15 - c);
      if (wid & 1) { head_step<0, 1>(o, m_reg, l_reg, K_lds + buf * SHM_T, vb0 + buf * SHM_T, qr, bp0, cs, r32, hi, al_l);
                     head_step<1, 1>(o, m_reg, l_reg, K_lds + buf * SHM_T, vb0 + buf * SHM_T, qr, bp0 + 465, cs, r32, hi, al_l); }
      else         { head_step<0, 0>(o, m_reg, l_reg, K_lds + buf * SHM_T, vb0 + buf * SHM_T, qr, bp0, cs, r32, hi, al_l);
                     head_step<1, 0>(o, m_reg, l_reg, K_lds + buf * SHM_T, vb0 + buf * SHM_T, qr, bp0 + 465, cs, r32, hi, al_l); }
    }
    __syncthreads();
  }
#undef NATM_SLOAD
#undef NATM_SWRITE
  float ssr[16];
#pragma unroll
  for (int r = 0; r < 16; ++r) ssr[r] = 0.f;
#pragma unroll
  for (int hh = 0; hh < 2; ++hh) {
    if (hi == 0) li_l[r32] = l_reg[hh]; asm volatile("s_waitcnt lgkmcnt(0)" ::: "memory");
    float rli[16];
#pragma unroll
    for (int r = 0; r < 16; ++r) rli[r] = __builtin_amdgcn_rcpf(li_l[crow(r, hi)]);
    asm volatile("s_waitcnt lgkmcnt(0)" ::: "memory");
    bf16_t* Ow = out + (tb + rw * 64 + 32 * (wid & 1)) * 2048 + hp * 128 + hh * 64;
#pragma unroll
    for (int r = 0; r < 16; ++r) { const int orow = crow(r, hi);
#pragma unroll
      for (int db = 0; db < 2; ++db) { const unsigned bv = f2bf(o[hh][db][r] * rli[r]); Ow[(long)orow * 2048 + db * 32 + r32] = (bf16_t)bv; const float fv = __uint_as_float(bv << 16); ssr[r] += fv * fv; } }
  }
  mla::half32_rowsum_store(ssr, lane, ssq + (tb + rw * 64 + 32 * (wid & 1)) * 8 + hp, 8);
}
}

constexpr size_t MiB = 1u << 20;
constexpr size_t WS_CTL = 0, WS_WIN = 4 * MiB, WS_WUQ = WS_WIN + 64 * MiB, WS_WUKV = WS_WUQ + 6 * MiB, WS_WOUT = WS_WUKV + 4 * MiB, WS_WPQ = WS_WOUT + 32 * MiB,
                 WS_U = WS_WPQ + 32 * MiB, WS_V = WS_U + 128 * MiB, WS_US = WS_V + 128 * MiB, WS_VS = WS_US + 1 * MiB, WS_RSS = WS_VS + 1 * MiB, WS_MSS = WS_RSS + 256 * 1024  , WS_KT = WS_RSS + 1 * MiB, WS_ROPE = WS_KT + 1 * MiB, WS_X32 = WS_ROPE + 1 * MiB,
                 WS_H = WS_X32 + 128 * MiB, WS_CQ = WS_H + 64 * MiB, WS_CKV = WS_CQ + 16 * MiB, WS_KPE = WS_CKV + 8 * MiB, WS_NQ = WS_KPE + 2 * MiB,
                 WS_NK = WS_NQ + 32 * MiB, WS_NV = WS_NK + 32 * MiB, WS_CQN = WS_NV + 32 * MiB, WS_CKVN = WS_CQN + 16 * MiB, WS_Q = WS_CKVN + 8 * MiB,
                 WS_KN = WS_Q + 48 * MiB, WS_VV = WS_KN + 32 * MiB, WS_MIX = WS_VV + 32 * MiB, WS_PQ = WS_MIX + 64 * MiB, WS_MP = WS_PQ + 64 * MiB  , WS_NP = WS_MP + 1 * MiB  ,
                 WS_XP = WS_NP + 1 * MiB  , WS_LP = WS_XP + 2 * MiB  , WS_END = WS_LP + 1 * MiB;
constexpr int LDS_BYTES = 155648, LDS_BAR_OFF = 153600;
#define LDS_WAIT() asm volatile("s_waitcnt lgkmcnt(0)" ::: "memory")

struct MkArgs { const float* in[17]; float* out; unsigned char* ws; };

__device__ __forceinline__ void transpose_item(const float* __restrict__ W, int K, int N, int NP, int mode, bf16_t* __restrict__ WT, LAS float* scr, int item, int lane, const float* __restrict__ kgain) {
    const int nblk = NP / 32, kb = item / nblk, nb = item % nblk, k0 = 64 * kb, n0 = 32 * nb;
    const int kk0 = lane >> 3, nq = (lane & 7) * 4;
    const int s0 = src_col(mode, n0 + nq), s1 = src_col(mode, n0 + nq + 1), s2 = src_col(mode, n0 + nq + 2), s3 = src_col(mode, n0 + nq + 3);
    const bool contig = (s0 >= 0) && (s1 == s0 + 1) && (s2 == s0 + 2) && (s3 == s0 + 3) && ((s0 & 3) == 0) && ((N & 3) == 0);
#pragma unroll
    for (int i = 0; i < 8; ++i) { const int kk = 8 * i + kk0; const float* wr = W + (size_t)(k0 + kk) * N; f32x4 v;
        if (contig) v = *(const f32x4*)(wr + s0);
        else { v.x = s0 >= 0 ? wr[s0] : 0.f; v.y = s1 >= 0 ? wr[s1] : 0.f; v.z = s2 >= 0 ? wr[s2] : 0.f; v.w = s3 >= 0 ? wr[s3] : 0.f; }
        if (kgain) { const float g = kgain[k0 + kk]; v = v * g; }
        LAS float* d = scr + kk * 33 + nq; d[0] = v.x; d[1] = v.y; d[2] = v.z; d[3] = v.w; }
    LDS_WAIT();
    const int c = lane & 7;
#pragma unroll
    for (int j = 0; j < 4; ++j) { const int n = (lane >> 3) + 8 * j; const LAS float* s = scr + (8 * c) * 33 + n;
        u32x4 o; o.x = pk2(s[0 * 33], s[1 * 33]); o.y = pk2(s[2 * 33], s[3 * 33]); o.z = pk2(s[4 * 33], s[5 * 33]); o.w = pk2(s[6 * 33], s[7 * 33]);
        *(u32x4*)(WT + (size_t)(n0 + n) * K + k0 + 8 * c) = o; }
    LDS_WAIT();
}
__device__ __forceinline__ void conv_w_all(const float* __restrict__ W, bf16_t* __restrict__ WT, int K, int N, int NP, int mode, LAS float* scr, int gw, int NGW, int lane, const float* __restrict__ kgain = nullptr, const float* __restrict__ kgain2 = nullptr) {
    const int per = (K / 64) * (NP / 32);
    for (int it = gw; it < NL * per; it += NGW) { const int l = it / per, r = it % per; const int k0 = 64 * (r / (NP / 32));
        const float* kg = !kgain ? nullptr : !kgain2 ? kgain + (size_t)l * K : (k0 < K / 2 ? kgain + (size_t)l * (K / 2) : kgain2 + (size_t)l * (K / 2) - K / 2);
        transpose_item(W + (size_t)l * K * N, K, N, NP, mode, WT + (size_t)l * NP * K, scr, r, lane, kg); }
}
__device__ __forceinline__ void conv_bf16_all(const float* __restrict__ in, bf16_t* __restrict__ out, size_t n8, size_t gt, size_t NGT) {
    for (size_t i = gt; i < n8; i += NGT) {
        const f32x4 a = ((const f32x4*)in)[2 * i], b = ((const f32x4*)in)[2 * i + 1];
        u32x4 o; o.x = pk2(a.x, a.y); o.y = pk2(a.z, a.w); o.z = pk2(b.x, b.y); o.w = pk2(b.z, b.w);
        ((u32x4*)out)[i] = o; }
}
__device__ const double ROPE_REV[32] = {0.15915494309189535, 0.11934937021124886, 0.08949940160889101, 0.06711508300522726, 0.050329212104487035, 0.03774158471741977, 0.0283021958306234, 0.02122365276477766, 0.015915494309189534, 0.011934937021124886, 0.008949940160889102, 0.006711508300522725, 0.005032921210448704, 0.003774158471741977, 0.00283021958306234, 0.0021223652764777662, 0.0015915494309189536, 0.0011934937021124885, 0.0008949940160889102, 0.0006711508300522726, 0.0005032921210448703, 0.00037741584717419774, 0.00028302195830623395, 0.0002122365276477766, 0.00015915494309189535, 0.00011934937021124886, 8.949940160889102e-05, 6.711508300522725e-05, 5.0329212104487035e-05, 3.774158471741978e-05, 2.8302195830623396e-05, 2.122365276477766e-05};

__device__ __forceinline__ void norm_x_row(const float* __restrict__ xr, const float* __restrict__ gain, bf16_t* __restrict__ hr, bf16_t* __restrict__ xc, int lane) {
    f32x4 v[8]; float ss = 0.f;
#pragma unroll
    for (int j = 0; j < 4; ++j) { v[2 * j] = *(const f32x4*)(xr + j * 512 + lane * 8); v[2 * j + 1] = *(const f32x4*)(xr + j * 512 + lane * 8 + 4); }
#pragma unroll
    for (int j = 0; j < 8; ++j) ss += v[j].x * v[j].x + v[j].y * v[j].y + v[j].z * v[j].z + v[j].w * v[j].w;
    const float r = 1.0f / sqrtf(wave_sum(ss) * (1.0f / D) + EPS);
#pragma unroll
    for (int j = 0; j < 4; ++j) {
        const f32x4 g0 = *(const f32x4*)(gain + j * 512 + lane * 8), g1 = *(const f32x4*)(gain + j * 512 + lane * 8 + 4);
        const f32x4 a = v[2 * j], b = v[2 * j + 1];
        u32x4 o; o.x = pk2(a.x * r * g0.x, a.y * r * g0.y); o.y = pk2(a.z * r * g0.z, a.w * r * g0.w); o.z = pk2(b.x * r * g1.x, b.y * r * g1.y); o.w = pk2(b.z * r * g1.z, b.w * r * g1.w);
        *(u32x4*)(hr + j * 512 + lane * 8) = o;
        if (xc) { u32x4 q; q.x = pk2(a.x, a.y); q.y = pk2(a.z, a.w); q.z = pk2(b.x, b.y); q.w = pk2(b.z, b.w); *(u32x4*)(xc + j * 512 + lane * 8) = q; }
    }
}
__device__ __forceinline__ void lat_norm_row(int t, int lane, const bf16_t* __restrict__ cq, const bf16_t* __restrict__ ckv, const float* __restrict__ gq, const float* __restrict__ gkv, bf16_t* __restrict__ cqn, bf16_t* __restrict__ ckvn) {
    { const u32x4 a = *(const u32x4*)(cq + (size_t)t * 512 + lane * 8);
      float f[8] = {bflo(a.x), bfhi(a.x), bflo(a.y), bfhi(a.y), bflo(a.z), bfhi(a.z), bflo(a.w), bfhi(a.w)};
      float ss = 0.f;
#pragma unroll
      for (int i = 0; i < 8; ++i) ss += f[i] * f[i];
      const float r = 1.0f / sqrtf(wave_sum(ss) * (1.0f / 512) + EPS);
      const f32x4 g0 = *(const f32x4*)(gq + lane * 8), g1 = *(const f32x4*)(gq + lane * 8 + 4);
      u32x4 o; o.x = pk2(f[0] * r * g0.x, f[1] * r * g0.y); o.y = pk2(f[2] * r * g0.z, f[3] * r * g0.w); o.z = pk2(f[4] * r * g1.x, f[5] * r * g1.y); o.w = pk2(f[6] * r * g1.z, f[7] * r * g1.w);
      *(u32x4*)(cqn + (size_t)t * 512 + lane * 8) = o; }
    { const u32x2 a = *(const u32x2*)(ckv + (size_t)t * 256 + lane * 4);
      float f[4] = {bflo(a.x), bfhi(a.x), bflo(a.y), bfhi(a.y)};
      const float ss = f[0] * f[0] + f[1] * f[1] + f[2] * f[2] + f[3] * f[3];
      const float r = 1.0f / sqrtf(wave_sum(ss) * (1.0f / 256) + EPS);
      const f32x4 g = *(const f32x4*)(gkv + lane * 4);
      u32x2 o; o.x = pk2(f[0] * r * g.x, f[1] * r * g.y); o.y = pk2(f[2] * r * g.z, f[3] * r * g.w);
      *(u32x2*)(ckvn + (size_t)t * 256 + lane * 4) = o; }
}
__device__ __forceinline__ void unpack16(const bf16_t* p, float (&f)[16]) {
    const u32x4 a = *(const u32x4*)p, b = *(const u32x4*)(p + 8);
    f[0] = bflo(a.x); f[1] = bfhi(a.x); f[2] = bflo(a.y); f[3] = bfhi(a.y); f[4] = bflo(a.z); f[5] = bfhi(a.z); f[6] = bflo(a.w); f[7] = bfhi(a.w);
    f[8] = bflo(b.x); f[9] = bfhi(b.x); f[10] = bflo(b.y); f[11] = bfhi(b.y); f[12] = bflo(b.z); f[13] = bfhi(b.z); f[14] = bflo(b.w); f[15] = bfhi(b.w);
}
__device__ __forceinline__ void norm16_store(float (&o)[16], float rr, const float* __restrict__ g, bf16_t* __restrict__ dst) {
    float gg[16];
#pragma unroll
    for (int i = 0; i < 4; ++i) { const f32x4 q = *(const f32x4*)(g + 4 * i); gg[4 * i] = q.x; gg[4 * i + 1] = q.y; gg[4 * i + 2] = q.z; gg[4 * i + 3] = q.w; }
    u32x4 o0, o1;
    o0.x = pk2(o[0] * rr * gg[0], o[1] * rr * gg[1]); o0.y = pk2(o[2] * rr * gg[2], o[3] * rr * gg[3]); o0.z = pk2(o[4] * rr * gg[4], o[5] * rr * gg[5]); o0.w = pk2(o[6] * rr * gg[6], o[7] * rr * gg[7]);
    o1.x = pk2(o[8] * rr * gg[8], o[9] * rr * gg[9]); o1.y = pk2(o[10] * rr * gg[10], o[11] * rr * gg[11]); o1.z = pk2(o[12] * rr * gg[12], o[13] * rr * gg[13]); o1.w = pk2(o[14] * rr * gg[14], o[15] * rr * gg[15]);
    *(u32x4*)dst = o0; *(u32x4*)(dst + 8) = o1;
}
__device__ __forceinline__ void mla_norm_row(int t, int lane, bf16_t* __restrict__ mix, const float* __restrict__ g) {
    bf16_t* p = mix + (size_t)t * 2048 + lane * 16;
    float f[16]; unpack16(p, f);
    float ss = 0.f;
#pragma unroll
    for (int i = 0; i < 16; ++i) ss += f[i] * f[i];
    const float r = 1.0f / sqrtf(wave_sum(ss) * (1.0f / 1024) + EPS);
    norm16_store(f, r, g + lane * 16, p);
}
__device__ __forceinline__ float dpp_quad_sum(float s) {
    s += __int_as_float(__builtin_amdgcn_mov_dpp(__float_as_int(s), 0xB1, 0xF, 0xF, true));
    s += __int_as_float(__builtin_amdgcn_mov_dpp(__float_as_int(s), 0x4E, 0xF, 0xF, true));
    return s;
}
typedef __bf16 cvtpk_bf16_b2 __attribute__((ext_vector_type(2))); typedef float cvtpk_bf16_f2 __attribute__((ext_vector_type(2)));
__device__ __forceinline__ unsigned cvtpk_bf16(float lo, float hi) { const cvtpk_bf16_f2 v = {lo, hi}; return __builtin_bit_cast(unsigned, __builtin_convertvector(v, cvtpk_bf16_b2)); }
#define NAT_PV2(wa, wb, ep, j) do { const unsigned lo_ = __builtin_amdgcn_perm((wb), (wa), 0x05040100u), hi_ = __builtin_amdgcn_perm((wb), (wa), 0x07060302u); \
    o[2 * (j)] = dot2(lo_, (ep), o[2 * (j)]); o[2 * (j) + 1] = dot2(hi_, (ep), o[2 * (j) + 1]); } while (0)
__device__ __forceinline__ void nat_token(int t, int lane, const LAS float* rp, const bf16_t* __restrict__ nq, const bf16_t* __restrict__ nk, const bf16_t* __restrict__ nv, const float* __restrict__ gain, bf16_t* __restrict__ mix) {
    const int b = t >> 11, s = t & 2047, r = s >> 6, c = s & 63;
    const int rs = min(max(r - 4, 0), 24), cs = min(max(c - 8, 0), 48), hd = lane >> 2;
    const u32x4 qa = *(const u32x4*)(nq + (size_t)t * 1024 + lane * 16), qb = *(const u32x4*)(nq + (size_t)t * 1024 + lane * 16 + 8);
    const LAS float* rph = rp + hd * 465 + (rs - r + 7) * 31 + (cs - c + 15);
    const size_t kb = ((size_t)b * 2048 + rs * 64 + cs) * 1024 + lane * 16;
    float m = -1e30f, l = 0.f, o[16];
#pragma unroll
    for (int i = 0; i < 16; ++i) o[i] = 0.f;
    u32x4 K0[4][2], V0[4][2], K1[4][2], V1[4][2];
#define NAT_LOAD(KK, VV, cc) do { const size_t off_ = kb + (size_t)((((cc) >> 2) * 64 + ((cc) & 3) * 4) * 1024); _Pragma("unroll") for (int i_ = 0; i_ < 4; ++i_) { \
        KK[i_][0] = *(const u32x4*)(nk + off_ + i_ * 1024); KK[i_][1] = *(const u32x4*)(nk + off_ + i_ * 1024 + 8); VV[i_][0] = *(const u32x4*)(nv + off_ + i_ * 1024); VV[i_][1] = *(const u32x4*)(nv + off_ + i_ * 1024 + 8); } } while (0)
#define NAT_COMP(KK, VV, cc) do { float s_[4]; const LAS float* bp_ = rph + ((cc) >> 2) * 31 + ((cc) & 3) * 4; \
        _Pragma("unroll") for (int i_ = 0; i_ < 4; ++i_) { float a_ = 0.f; \
            a_ = dot2(KK[i_][0].x, qa.x, a_); a_ = dot2(KK[i_][0].y, qa.y, a_); a_ = dot2(KK[i_][0].z, qa.z, a_); a_ = dot2(KK[i_][0].w, qa.w, a_); \
            a_ = dot2(KK[i_][1].x, qb.x, a_); a_ = dot2(KK[i_][1].y, qb.y, a_); a_ = dot2(KK[i_][1].z, qb.z, a_); a_ = dot2(KK[i_][1].w, qb.w, a_); \
            s_[i_] = dpp_quad_sum(a_) + bp_[i_]; } \
        const float mn_ = fmaxf(fmaxf(m, fmaxf(s_[0], s_[1])), fmaxf(s_[2], s_[3])), al_ = __expf(m - mn_); \
        const float e0_ = __expf(s_[0] - mn_), e1_ = __expf(s_[1] - mn_), e2_ = __expf(s_[2] - mn_), e3_ = __expf(s_[3] - mn_); \
        l = l * al_ + ((e0_ + e1_) + (e2_ + e3_)); m = mn_; \
        _Pragma("unroll") for (int i_ = 0; i_ < 16; ++i_) o[i_] *= al_; \
        const unsigned p01_ = cvtpk_bf16(e0_, e1_), p23_ = cvtpk_bf16(e2_, e3_); \
        NAT_PV2(VV[0][0].x, VV[1][0].x, p01_, 0); NAT_PV2(VV[0][0].y, VV[1][0].y, p01_, 1); NAT_PV2(VV[0][0].z, VV[1][0].z, p01_, 2); NAT_PV2(VV[0][0].w, VV[1][0].w, p01_, 3); \
        NAT_PV2(VV[0][1].x, VV[1][1].x, p01_, 4); NAT_PV2(VV[0][1].y, VV[1][1].y, p01_, 5); NAT_PV2(VV[0][1].z, VV[1][1].z, p01_, 6); NAT_PV2(VV[0][1].w, VV[1][1].w, p01_, 7); \
        NAT_PV2(VV[2][0].x, VV[3][0].x, p23_, 0); NAT_PV2(VV[2][0].y, VV[3][0].y, p23_, 1); NAT_PV2(VV[2][0].z, VV[3][0].z, p23_, 2); NAT_PV2(VV[2][0].w, VV[3][0].w, p23_, 3); \
        NAT_PV2(VV[2][1].x, VV[3][1].x, p23_, 4); NAT_PV2(VV[2][1].y, VV[3][1].y, p23_, 5); NAT_PV2(VV[2][1].z, VV[3][1].z, p23_, 6); NAT_PV2(VV[2][1].w, VV[3][1].w, p23_, 7); } while (0)
    NAT_LOAD(K0, V0, 0);
    for (int cc = 0; cc < 32; cc += 2) {
        NAT_LOAD(K1, V1, cc + 1);
        NAT_COMP(K0, V0, cc);
        if (cc + 2 < 32) NAT_LOAD(K0, V0, cc + 2);
        NAT_COMP(K1, V1, cc + 1);
    }
#undef NAT_LOAD
#undef NAT_COMP
    const float il = 1.0f / l; float ss = 0.f;
#pragma unroll
    for (int i = 0; i < 16; ++i) { o[i] *= il; ss += o[i] * o[i]; }
    const float rr = 1.0f / sqrtf(wave_sum(ss) * (1.0f / 1024) + EPS);
    norm16_store(o, rr, gain + lane * 16, mix + (size_t)t * 2048 + 1024 + lane * 16);
}

__device__ __forceinline__ void st8f(LAS float* d, u32x4 v) { d[0] = bflo(v.x); d[1] = bfhi(v.x); d[2] = bflo(v.y); d[3] = bfhi(v.y); d[4] = bflo(v.z); d[5] = bfhi(v.z); d[6] = bflo(v.w); d[7] = bfhi(v.w); }
__device__ __forceinline__ void mla_unit(int unit, int tid, LAS unsigned char* lds, const bf16_t* __restrict__ Q, const bf16_t* __restrict__ Kn, const bf16_t* __restrict__ Vv, const bf16_t* __restrict__ kpe, bf16_t* __restrict__ mix) {
    LAS float* Qs = (LAS float*)lds; LAS float* Ks = Qs + 64 * 196; LAS float* Vs = Ks + 64 * 196; LAS float* Pt = Vs + 64 * 128;
    const int lane = tid & 63, w = tid >> 6;
    const int qb = unit & 31, hd = (unit >> 5) & 7, b = unit >> 8;
    const size_t t0 = (size_t)b * 2048 + qb * 64;
    __syncthreads();
    for (int i = tid; i < 64 * 24; i += 512) { const int r = i / 24, ch = i % 24; st8f(Qs + r * 196 + ch * 8, *(const u32x4*)(Q + (t0 + r) * 1536 + hd * 192 + ch * 8)); }
    float m[8], l[8], o0[8], o1[8];
#pragma unroll
    for (int i = 0; i < 8; ++i) { m[i] = -INFINITY; l[i] = 0.f; o0[i] = 0.f; o1[i] = 0.f; }
    LAS float* P = Pt + w * 512;
    for (int kt = 0; kt < 32; ++kt) {
        __syncthreads();
        const size_t k0 = (size_t)b * 2048 + kt * 64;
        for (int i = tid; i < 64 * 24; i += 512) { const int r = i / 24, ch = i % 24;
            const bf16_t* src = ch < 16 ? Kn + (k0 + r) * 1024 + hd * 128 + ch * 8 : kpe + (k0 + r) * 64 + (ch - 16) * 8;
            st8f(Ks + r * 196 + ch * 8, *(const u32x4*)src); }
        for (int i = tid; i < 64 * 16; i += 512) { const int r = i / 16, ch = i % 16; st8f(Vs + r * 128 + ch * 8, *(const u32x4*)(Vv + (k0 + r) * 1024 + hd * 128 + ch * 8)); }
        __syncthreads();
#pragma unroll
        for (int qi = 0; qi < 8; ++qi) {
            const LAS f32x4* qp = (const LAS f32x4*)(Qs + (w * 8 + qi) * 196); const LAS f32x4* kp = (const LAS f32x4*)(Ks + lane * 196);
            float s = 0.f;
#pragma unroll 8
            for (int d = 0; d < 48; ++d) { const f32x4 a = qp[d], k = kp[d]; s += a.x * k.x + a.y * k.y + a.z * k.z + a.w * k.w; }
            const float mx = wave_max(s), mn = fmaxf(m[qi], mx), alpha = __expf(m[qi] - mn), p = __expf(s - mn), ps = wave_sum(p);
            l[qi] = l[qi] * alpha + ps; m[qi] = mn; o0[qi] *= alpha; o1[qi] *= alpha;
            P[lane * 8 + qi] = p;
        }
        for (int key = 0; key < 64; ++key) {
            const f32x4 pa = *(const LAS f32x4*)(P + key * 8), pb = *(const LAS f32x4*)(P + key * 8 + 4);
            const float v0 = Vs[key * 128 + lane], v1 = Vs[key * 128 + 64 + lane];
            o0[0] += pa.x * v0; o1[0] += pa.x * v1; o0[1] += pa.y * v0; o1[1] += pa.y * v1; o0[2] += pa.z * v0; o1[2] += pa.z * v1; o0[3] += pa.w * v0; o1[3] += pa.w * v1;
            o0[4] += pb.x * v0; o1[4] += pb.x * v1; o0[5] += pb.y * v0; o1[5] += pb.y * v1; o0[6] += pb.z * v0; o1[6] += pb.z * v1; o0[7] += pb.w * v0; o1[7] += pb.w * v1;
        }
    }
#pragma unroll
    for (int qi = 0; qi < 8; ++qi) { const float il = 1.0f / l[qi]; bf16_t* dst = mix + (t0 + w * 8 + qi) * 2048 + hd * 128;
        dst[lane] = (bf16_t)f2bf(o0[qi] * il); dst[64 + lane] = (bf16_t)f2bf(o1[qi] * il); }
}

typedef short rt_bf16x8 __attribute__((ext_vector_type(8)));
template <int C> __device__ __forceinline__ int dppi(int v) { return __builtin_amdgcn_mov_dpp(v, C, 0xF, 0xF, true); }
template <int C> __device__ __forceinline__ float dppf(float v) { return __int_as_float(__builtin_amdgcn_mov_dpp(__float_as_int(v), C, 0xF, 0xF, true)); }
__device__ __forceinline__ int row16_sum(int v) { v += dppi<0xB1>(v); v += dppi<0x4E>(v); v += dppi<0x141>(v); v += dppi<0x140>(v); return v; }
__device__ __forceinline__ int grp8_sum(int v) { v += dppi<0xB1>(v); v += dppi<0x4E>(v); v += dppi<0x141>(v); return v; }
__device__ __forceinline__ float row16_sumf(float v) { v += dppf<0xB1>(v); v += dppf<0x4E>(v); v += dppf<0x141>(v); v += dppf<0x140>(v); return v; }
__device__ __forceinline__ float row16_maxf(float v) { v = fmaxf(v, dppf<0xB1>(v)); v = fmaxf(v, dppf<0x4E>(v)); v = fmaxf(v, dppf<0x141>(v)); v = fmaxf(v, dppf<0x140>(v)); return v; }
__device__ __forceinline__ unsigned umaxu(unsigned a, unsigned b) { return a > b ? a : b; }
__device__ __forceinline__ unsigned row16_maxu(unsigned v) { v = umaxu(v, (unsigned)dppi<0xB1>((int)v)); v = umaxu(v, (unsigned)dppi<0x4E>((int)v)); v = umaxu(v, (unsigned)dppi<0x141>((int)v)); v = umaxu(v, (unsigned)dppi<0x140>((int)v)); return v; }
__device__ __forceinline__ unsigned grp8_maxu(unsigned v) { v = umaxu(v, (unsigned)dppi<0xB1>((int)v)); v = umaxu(v, (unsigned)dppi<0x4E>((int)v)); v = umaxu(v, (unsigned)dppi<0x141>((int)v)); return v; }
__device__ __forceinline__ int row16_incl_scan(int v) { v += dppi<0x111>(v); v += dppi<0x112>(v); v += dppi<0x114>(v); v += dppi<0x118>(v); return v; }
__device__ __forceinline__ int grp8_incl_scan(int v, int lane) { int t = dppi<0x111>(v); if ((lane & 7) >= 1) v += t; t = dppi<0x112>(v); if ((lane & 7) >= 2) v += t; t = dppi<0x114>(v); if ((lane & 7) >= 4) v += t; return v; }
__device__ __forceinline__ unsigned fkey(float f) { const unsigned u = __float_as_uint(f); return u ^ ((unsigned)((int)u >> 31) | 0x80000000u); }
__device__ __forceinline__ float funkey(unsigned k) { return __uint_as_float((k & 0x80000000u) ? (k ^ 0x80000000u) : ~k); }
__device__ __forceinline__ void peer_load_q(int t, int lane, const bf16_t* __restrict__ pq, rt_bf16x8 (&aq)[4]) {
    const int col = lane & 15, quad = lane >> 4; const bf16_t* qp = pq + (size_t)t * 2048 + (col & 7) * 256 + (col >> 3) * 128 + quad * 8;
#pragma unroll
    for (int ks = 0; ks < 4; ++ks) aq[ks] = *(const rt_bf16x8*)(qp + ks * 32);
}
__device__ __forceinline__ void peer_route(int lane, const LAS unsigned char* keys, LAS float* Lv, LAS int* Ln, LAS int* idxs, LAS float* gs, const rt_bf16x8 (&aqv)[4]) {
    const int col = lane & 15, quad = lane >> 4;
    unsigned uk[8][4];
    {
        rt_bf16x8 a1[4], a2[4]; const rt_bf16x8 zero = {0, 0, 0, 0, 0, 0, 0, 0};
#pragma unroll
        for (int ks = 0; ks < 4; ++ks) { const rt_bf16x8 aq = aqv[ks]; a1[ks] = col < 8 ? aq : zero; a2[ks] = col >= 8 ? aq : zero; }
#pragma unroll
        for (int nt = 0; nt < 8; ++nt) { pg8::f32x4 acc = {0.f, 0.f, 0.f, 0.f};
#pragma unroll
            for (int ks = 0; ks < 4; ++ks) {
                const rt_bf16x8 b1 = *(const LAS rt_bf16x8*)(keys + (16 * nt + col) * 272 + (ks * 32 + quad * 8) * 2);
                const rt_bf16x8 b2 = *(const LAS rt_bf16x8*)(keys + (128 + 16 * nt + col) * 272 + (ks * 32 + quad * 8) * 2);
                acc = __builtin_amdgcn_mfma_f32_16x16x32_bf16(a1[ks], b1, acc, 0, 0, 0);
                acc = __builtin_amdgcn_mfma_f32_16x16x32_bf16(a2[ks], b2, acc, 0, 0, 0); }
            uk[nt][0] = fkey(acc.x); uk[nt][1] = fkey(acc.y); uk[nt][2] = fkey(acc.z); uk[nt][3] = fkey(acc.w); }
    }
    {
        unsigned thr[4] = {0u, 0u, 0u, 0u}; unsigned fin = 0u; int bit0 = 31;
        {
            unsigned t0[4]; unsigned f0 = 0u; bool ok = true;
#pragma unroll
            for (int r = 0; r < 4; ++r) { unsigned mx = uk[0][r];
#pragma unroll
                for (int nt = 1; nt < 8; ++nt) mx = umaxu(mx, uk[nt][r]);
                t0[r] = row16_maxu(mx) & 0xFF000000u; int c = 0;
#pragma unroll
                for (int nt = 0; nt < 8; ++nt) c += (uk[nt][r] >= t0[r]) ? 1 : 0;
                c = row16_sum(c); ok = ok && (c >= 16); if (c == 16) f0 |= 1u << r; }
            if (__all(ok)) { thr[0] = t0[0]; thr[1] = t0[1]; thr[2] = t0[2]; thr[3] = t0[3]; fin = f0; bit0 = 23; }
        }
        for (int bit = bit0; bit >= 0; --bit) {
            if (__all(fin == 15u)) break;
            const unsigned m = 1u << bit;
#pragma unroll
            for (int r = 0; r < 4; ++r) { const unsigned cand = thr[r] | m; int c = 0;
#pragma unroll
                for (int nt = 0; nt < 8; ++nt) c += (uk[nt][r] >= cand) ? 1 : 0;
                c = row16_sum(c);
                const bool open = ((fin >> r) & 1u) == 0u;
                if (open && c >= 16) thr[r] = cand;
                if (open && c == 16) fin |= 1u << r; }
        }
        const bool ties = !__all(fin == 15u);
#pragma unroll
        for (int r = 0; r < 4; ++r) { const bool exact = ((fin >> r) & 1u) != 0u; const unsigned thrx = exact ? thr[r] - 1u : thr[r]; const int rowb = (4 * quad + r) * 16;
            int cl = 0;
#pragma unroll
            for (int nt = 0; nt < 8; ++nt) cl += (uk[nt][r] > thrx) ? 1 : 0;
            int p = row16_incl_scan(cl) - cl;
#pragma unroll
            for (int nt = 0; nt < 8; ++nt) if (uk[nt][r] > thrx) { if (p < 16) { Lv[rowb + p] = funkey(uk[nt][r]); Ln[rowb + p] = 16 * nt + col; } ++p; }
            if (ties) {
                const int tot = row16_sum(cl); int tl = 0;
#pragma unroll
                for (int nt = 0; nt < 8; ++nt) tl += (uk[nt][r] == thrx) ? 1 : 0;
                int p2 = tot + row16_incl_scan(tl) - tl;
#pragma unroll
                for (int nt = 0; nt < 8; ++nt) if (uk[nt][r] == thrx) { if (!exact && p2 < 16) { Lv[rowb + p2] = funkey(uk[nt][r]); Ln[rowb + p2] = 16 * nt + col; } ++p2; }
            }
        }
    }
    {
        const int hd = lane >> 3, sub = lane & 7;
        float v2[16];
#pragma unroll
        for (int i = 0; i < 4; ++i) { const f32x4 q = *(const LAS f32x4*)(Lv + (8 + hd) * 16 + 4 * i); v2[4 * i] = q.x; v2[4 * i + 1] = q.y; v2[4 * i + 2] = q.z; v2[4 * i + 3] = q.w; }
        const float v1a = Lv[hd * 16 + 2 * sub], v1b = Lv[hd * 16 + 2 * sub + 1];
        unsigned ck[32];
#pragma unroll
        for (int b = 0; b < 16; ++b) { ck[b] = fkey(v1a + v2[b]); ck[16 + b] = fkey(v1b + v2[b]); }
        unsigned thr = 0u; bool fin = false; int bit0 = 31;
        {   unsigned mx = ck[0];
#pragma unroll
            for (int i = 1; i < 32; ++i) mx = umaxu(mx, ck[i]);
            const unsigned t0 = grp8_maxu(mx) & 0xFF000000u; int c = 0;
#pragma unroll
            for (int i = 0; i < 32; ++i) c += (ck[i] >= t0) ? 1 : 0;
            c = grp8_sum(c);
            if (__all(c >= 16)) { thr = t0; fin = (c == 16); bit0 = 23; }
        }
        for (int bit = bit0; bit >= 0; --bit) {
            if (__all(fin)) break;
            const unsigned cand = thr | (1u << bit); int c = 0;
#pragma unroll
            for (int i = 0; i < 32; ++i) c += (ck[i] >= cand) ? 1 : 0;
            c = grp8_sum(c);
            if (!fin && c >= 16) thr = cand;
            if (!fin && c == 16) fin = true;
        }
        const bool ties = !__all(fin);
        const unsigned thrx = fin ? thr - 1u : thr;
        const int n1a = Ln[hd * 16 + 2 * sub], n1b = Ln[hd * 16 + 2 * sub + 1];
        int cl = 0;
#pragma unroll
        for (int i = 0; i < 32; ++i) cl += (ck[i] > thrx) ? 1 : 0;
        int p = grp8_incl_scan(cl, lane) - cl;
#pragma unroll
        for (int i = 0; i < 32; ++i) if (ck[i] > thrx) { if (p < 16) { idxs[hd * 16 + p] = (i < 16 ? n1a : n1b) * 128 + Ln[(8 + hd) * 16 + (i & 15)]; gs[hd * 16 + p] = funkey(ck[i]); } ++p; }
        if (ties) {
            const int tot = grp8_sum(cl); int tl = 0;
#pragma unroll
            for (int i = 0; i < 32; ++i) tl += (ck[i] == thrx) ? 1 : 0;
            int p2 = tot + grp8_incl_scan(tl, lane) - tl;
#pragma unroll
            for (int i = 0; i < 32; ++i) if (ck[i] == thrx) { if (!fin && p2 < 16) { idxs[hd * 16 + p2] = (i < 16 ? n1a : n1b) * 128 + Ln[(8 + hd) * 16 + (i & 15)]; gs[hd * 16 + p2] = funkey(ck[i]); } ++p2; }
        }
    }
    {
        const float s0 = gs[lane], s1 = gs[64 + lane];
        const float e0 = __expf(s0 - row16_maxf(s0)), e1 = __expf(s1 - row16_maxf(s1));
        gs[lane] = e0 / row16_sumf(e0); gs[64 + lane] = e1 / row16_sumf(e1);
    }
}

constexpr int PROW = 1024;
__device__ __forceinline__ void quant_load(f32x4 (&v)[8], const float* __restrict__ src, int lane) {
#pragma unroll
    for (int c = 0; c < 8; ++c) v[c] = *(const f32x4*)(src + 256 * c + 4 * lane);
}
__device__ __forceinline__ void quant_finish(const f32x4 (&v)[8], unsigned char* __restrict__ dst, bf16_t* __restrict__ scl, int lane, unsigned nibxor) {
    float am = 0.f;
#pragma unroll
    for (int i = 0; i < 8; ++i) am = fmaxf(am, fmaxf(fmaxf(fabsf(v[i].x), fabsf(v[i].y)), fmaxf(fabsf(v[i].z), fabsf(v[i].w))));
    am = fmaxf(am, dppf<0xB1>(am)); am = fmaxf(am, dppf<0x4E>(am)); am = fmaxf(am, dppf<0x141>(am)); am = fmaxf(am, dppf<0x140>(am)); am = fmaxf(am, __shfl_xor(am, 16)); am = fmaxf(am, __shfl_xor(am, 32));
    const unsigned sb = f2bf(am * (2.0f / 15.0f)); const float step = __uint_as_float(sb << 16);
    const float inv = step > 0.f ? 1.0f / step : 0.f;
    unsigned o[4];
#pragma unroll
    for (int d = 0; d < 4; ++d) { const f32x4 lo = v[2 * d], hi = v[2 * d + 1];
        const int l0 = min(max((int)rintf(lo.x * inv + 7.5f), 0), 15), l1 = min(max((int)rintf(lo.y * inv + 7.5f), 0), 15), l2 = min(max((int)rintf(lo.z * inv + 7.5f), 0), 15), l3 = min(max((int)rintf(lo.w * inv + 7.5f), 0), 15);
        const int h0 = min(max((int)rintf(hi.x * inv + 7.5f), 0), 15), h1 = min(max((int)rintf(hi.y * inv + 7.5f), 0), 15), h2 = min(max((int)rintf(hi.z * inv + 7.5f), 0), 15), h3 = min(max((int)rintf(hi.w * inv + 7.5f), 0), 15);
        o[d] = (unsigned)(l0 | (h0 << 4)) | ((unsigned)(l1 | (h1 << 4)) << 8) | ((unsigned)(l2 | (h2 << 4)) << 16) | ((unsigned)(l3 | (h3 << 4)) << 24); }
    u32x4 w; w.x = o[0] ^ nibxor; w.y = o[1] ^ nibxor; w.z = o[2] ^ nibxor; w.w = o[3] ^ nibxor;
    *(u32x4*)(dst + 16 * lane) = w;
    if (lane == 0) scl[0] = (bf16_t)sb;
}
__device__ __forceinline__ float rdl_f(float v, int l) { return __int_as_float(__builtin_amdgcn_readlane(__float_as_int(v), l)); }
template <int N> __device__ __forceinline__ void bfly_step(float (&s)[64], int lane) {
#pragma unroll
    for (int i = 0; i < N; ++i) { const bool up = (lane & N) != 0; const float keep = up ? s[i + N] : s[i], send = up ? s[i] : s[i + N]; s[i] = keep + __shfl_xor(send, N); }
}
__device__ __forceinline__ float bfly_reduce64(float (&p)[64], int lane) {
#pragma unroll
    for (int i = 0; i < 32; ++i) { auto r = __builtin_amdgcn_permlane32_swap(__float_as_uint(p[i]), __float_as_uint(p[i + 32]), false, false); p[i] = __uint_as_float(r[0]) + __uint_as_float(r[1]); }
    bfly_step<16>(p, lane); bfly_step<8>(p, lane); bfly_step<4>(p, lane); bfly_step<2>(p, lane); bfly_step<1>(p, lane);
    return p[0];
}
#define PEER_RING 16
#define PEER_R1 24
__device__ __forceinline__ float peer_quad4(float a0, float a1, float a2, float a3, int lane) {
    const bool b0 = (lane & 1) != 0, b1 = (lane & 2) != 0;
    const float u0 = (b0 ? a1 : a0) + dppf<0xB1>(b0 ? a0 : a1), u1 = (b0 ? a3 : a2) + dppf<0xB1>(b0 ? a2 : a3);
    return (b1 ? u1 : u0) + dppf<0x4E>(b1 ? u0 : u1);
}
__device__ __forceinline__ float peer_reduce16(float (&g)[16], int lane) {
#pragma unroll
    for (int i = 0; i < 8; ++i) { auto r = __builtin_amdgcn_permlane32_swap(__float_as_uint(g[i]), __float_as_uint(g[i + 8]), false, false); g[i] = __uint_as_float(r[0]) + __uint_as_float(r[1]); }
#pragma unroll
    for (int i = 0; i < 4; ++i) { const bool up = (lane & 16) != 0; const float keep = up ? g[i + 4] : g[i], send = up ? g[i] : g[i + 4]; g[i] = keep + __shfl_xor(send, 16); }
#pragma unroll
    for (int i = 0; i < 2; ++i) { const bool up = (lane & 8) != 0; const float keep = up ? g[i + 2] : g[i], send = up ? g[i] : g[i + 2]; g[i] = keep + __shfl_xor(send, 8); }
    { const bool up = (lane & 4) != 0; const float keep = up ? g[1] : g[0], send = up ? g[0] : g[1]; g[0] = keep + __shfl_xor(send, 4); }
    return g[0];
}
__device__ __forceinline__ int wave_sumi(int v) {
#pragma unroll
    for (int o = 1; o < 64; o <<= 1) v += __shfl_xor(v, o);
    return v; }
__device__ __forceinline__ int peer_quad4i(int a0, int a1, int a2, int a3, int lane) {
    const bool b0 = (lane & 1) != 0, b1 = (lane & 2) != 0;
    const int u0 = (b0 ? a1 : a0) + dppi<0xB1>(b0 ? a0 : a1), u1 = (b0 ? a3 : a2) + dppi<0xB1>(b0 ? a2 : a3);
    return (b1 ? u1 : u0) + dppi<0x4E>(b1 ? u0 : u1);
}
__device__ __forceinline__ int peer_reduce16i(int (&g)[16], int lane) {
#pragma unroll
    for (int i = 0; i < 8; ++i) { auto r = __builtin_amdgcn_permlane32_swap((unsigned)g[i], (unsigned)g[i + 8], false, false); g[i] = (int)(r[0] + r[1]); }
#pragma unroll
    for (int i = 0; i < 4; ++i) { const bool up = (lane & 16) != 0; const int keep = up ? g[i + 4] : g[i], send = up ? g[i] : g[i + 4]; g[i] = keep + __shfl_xor(send, 16); }
#pragma unroll
    for (int i = 0; i < 2; ++i) { const bool up = (lane & 8) != 0; const int keep = up ? g[i + 2] : g[i], send = up ? g[i] : g[i + 2]; g[i] = keep + __shfl_xor(send, 8); }
    { const bool up = (lane & 4) != 0; const int keep = up ? g[1] : g[0], send = up ? g[0] : g[1]; g[0] = keep + __shfl_xor(send, 4); }
    return g[0];
}
__device__ __forceinline__ int dot8z(int a, int b) { return __builtin_amdgcn_sdot8(a, b, 0, false); }
#define PEER_LD(slot, TB, e) do { const int e_ = (e); bx[slot] = *(const u32x4*)(TB##q + (size_t)e_ * PROW + 16 * lane); } while (0)
#define PEER_DOT(slot, dst) do { int aa_, ab_; \
        aa_ = dot8z((int)bx[slot].x, ha[0]); ab_ = dot8z((int)bx[slot].x, hb[0]); aa_ = __builtin_amdgcn_sdot8((int)bx[slot].y, ha[1], aa_, false); ab_ = __builtin_amdgcn_sdot8((int)bx[slot].y, hb[1], ab_, false); \
        aa_ = __builtin_amdgcn_sdot8((int)bx[slot].z, ha[2], aa_, false); ab_ = __builtin_amdgcn_sdot8((int)bx[slot].z, hb[2], ab_, false); aa_ = __builtin_amdgcn_sdot8((int)bx[slot].w, ha[3], aa_, false); ab_ = __builtin_amdgcn_sdot8((int)bx[slot].w, hb[3], ab_, false); \
        dst = 16 * aa_ + ab_; } while (0)
typedef _Float16 peer_h2 __attribute__((ext_vector_type(2)));
__device__ __forceinline__ float peer_dot2h(unsigned nn, unsigned cc, float acc) { return __builtin_amdgcn_fdot2(__builtin_bit_cast(peer_h2, nn), __builtin_bit_cast(peer_h2, cc), acc, false); }
#define PEER_ACC16(wa, wb, base) do { const unsigned la_ = (wa) & 0x0F0F0F0Fu, ha_ = (wa), lb_ = (wb) & 0x0F0F0F0Fu, hb_ = (wb);     \
        y[(base) + 0] = peer_dot2h(__builtin_amdgcn_perm(lb_, la_, 0x0C040C00u), cpair, y[(base) + 0]); y[(base) + 1] = peer_dot2h(__builtin_amdgcn_perm(lb_, la_, 0x0C050C01u), cpair, y[(base) + 1]); \
        y[(base) + 2] = peer_dot2h(__builtin_amdgcn_perm(lb_, la_, 0x0C060C02u), cpair, y[(base) + 2]); y[(base) + 3] = peer_dot2h(__builtin_amdgcn_perm(lb_, la_, 0x0C070C03u), cpair, y[(base) + 3]); \
        y[(base) + 4] = peer_dot2h(__builtin_amdgcn_perm(hb_, ha_, 0x0C040C00u), cpair, y[(base) + 4]); y[(base) + 5] = peer_dot2h(__builtin_amdgcn_perm(hb_, ha_, 0x0C050C01u), cpair, y[(base) + 5]); \
        y[(base) + 6] = peer_dot2h(__builtin_amdgcn_perm(hb_, ha_, 0x0C060C02u), cpair, y[(base) + 6]); y[(base) + 7] = peer_dot2h(__builtin_amdgcn_perm(hb_, ha_, 0x0C070C03u), cpair, y[(base) + 7]); } while (0)
__device__ __forceinline__ f32x4 x16_unpack(u32x2 p) { f32x4 r; r.x = __uint_as_float(p.x << 16); r.y = __uint_as_float(p.x & 0xffff0000u); r.z = __uint_as_float(p.y << 16); r.w = __uint_as_float(p.y & 0xffff0000u); return r; }
__device__ __forceinline__ float peer_gate(float tot, float sh, float g) { const float act = tot * sh; return 0.5f * act * (1.0f + erff(act * 0.70710678118654752f)) * g; }
__device__ __forceinline__ void peer_stage1(int lane, const LAS int* idxs, const LAS float* gs, const unsigned char* __restrict__ Uq, const bf16_t* __restrict__ Us, const bf16_t* __restrict__ Vs,
                                            const u32x2 (&xin)[8], const float* __restrict__ gain_ffn, LAS unsigned* save) {
    const int e0 = idxs[lane], e1 = idxs[64 + lane]; const float g0 = gs[lane], g1 = gs[64 + lane];
    u32x4 bx[PEER_R1];
    const float su0 = __uint_as_float((unsigned)Us[e0] << 16), su1 = __uint_as_float((unsigned)Us[e1] << 16), sv0 = __uint_as_float((unsigned)Vs[e0] << 16), sv1 = __uint_as_float((unsigned)Vs[e1] << 16);
#pragma unroll
    for (int s_ = 0; s_ < PEER_R1; ++s_) PEER_LD(s_, U, __builtin_amdgcn_readlane(e0, s_));
    __builtin_amdgcn_sched_barrier(0);
    float hf[32]; float am = 0.f;
    { float ssx = 0.f;
#pragma unroll
      for (int c = 0; c < 8; ++c) { const f32x4 xv = x16_unpack(xin[c]); hf[4 * c] = xv.x; hf[4 * c + 1] = xv.y; hf[4 * c + 2] = xv.z; hf[4 * c + 3] = xv.w;
          ssx += (xv.x * xv.x + xv.y * xv.y) + (xv.z * xv.z + xv.w * xv.w); }
      const float rx = 1.0f / sqrtf(wave_sum(ssx) * (1.0f / D) + EPS);
#pragma unroll
      for (int c = 0; c < 8; ++c) { const f32x4 gv = *(const f32x4*)(gain_ffn + 256 * c + 4 * lane); hf[4 * c] *= rx * gv.x; hf[4 * c + 1] *= rx * gv.y; hf[4 * c + 2] *= rx * gv.z; hf[4 * c + 3] *= rx * gv.w; } }
#pragma unroll
    for (int i = 0; i < 32; ++i) am = fmaxf(am, fabsf(hf[i]));
    am = wave_max(am);
    const float inv = am > 0.f ? 119.0f / am : 0.f, sh = am * (1.0f / 119.0f);
    int ha[4], hb[4]; int hsum = 0;
#pragma unroll
    for (int d = 0; d < 4; ++d) { unsigned pa_ = 0u, pb_ = 0u;
#pragma unroll
        for (int e = 0; e < 8; ++e) { const int q = (int)rintf(hf[8 * d + e] * inv); const int a_ = (q + 8) >> 4, b_ = q - 16 * a_; hsum += q;
            const int sh_ = (e < 4) ? 8 * e : 8 * (e - 4) + 4; pa_ |= ((unsigned)a_ & 15u) << sh_; pb_ |= ((unsigned)b_ & 15u) << sh_; }
        ha[d] = (int)pa_; hb[d] = (int)pb_; }
    const float hoff = 0.5f * (float)wave_sumi(hsum);
    float a0, a1;
    { int g[16], pa[4];
#pragma unroll
      for (int k = 0; k < 64; ++k) { PEER_DOT(k % PEER_R1, pa[k & 3]);
          if (k + PEER_R1 < 64) PEER_LD(k % PEER_R1, U, __builtin_amdgcn_readlane(e0, k + PEER_R1)); else PEER_LD(k % PEER_R1, U, __builtin_amdgcn_readlane(e1, k + PEER_R1 - 64));
          if ((k & 3) == 3) g[k >> 2] = peer_quad4i(pa[0], pa[1], pa[2], pa[3], lane);
          __builtin_amdgcn_sched_barrier(0); }
      a0 = peer_gate(((float)peer_reduce16i(g, lane) + hoff) * su0, sh, g0) * sv0; }
    { int g[16], pa[4];
#pragma unroll
      for (int k = 0; k < 64; ++k) { PEER_DOT((64 + k) % PEER_R1, pa[k & 3]);
          if (64 + k + PEER_R1 < 128) PEER_LD((64 + k) % PEER_R1, U, __builtin_amdgcn_readlane(e1, k + PEER_R1));
          if ((k & 3) == 3) g[k >> 2] = peer_quad4i(pa[0], pa[1], pa[2], pa[3], lane);
          __builtin_amdgcn_sched_barrier(0); }
      a1 = peer_gate(((float)peer_reduce16i(g, lane) + hoff) * su1, sh, g1) * sv1; }
    save[lane] = (unsigned)e0 | ((unsigned)e1 << 16); save[64 + lane] = __float_as_uint(a0); save[128 + lane] = __float_as_uint(a1);
}
__device__ __forceinline__ void peer_stage3(int t, int lane, const LAS unsigned* save, const unsigned char* __restrict__ Vq, bf16_t* __restrict__ x16, bf16_t* __restrict__ h,
                                            const float* __restrict__ gain_next, float* __restrict__ out_final) {
    constexpr int PEER_S3 = 0;
    const unsigned ee = save[lane]; const int e0 = (int)(ee & 0xffffu), e1 = (int)(ee >> 16); const float a0 = __uint_as_float(save[64 + lane]), a1 = __uint_as_float(save[128 + lane]);
    u32x4 bx[PEER_RING];
#pragma unroll
    for (int s_ = 0; s_ < PEER_RING; ++s_) PEER_LD(s_, V, __builtin_amdgcn_readlane(e0, s_));
    __builtin_amdgcn_sched_barrier(0);
    float y[32]; float csum = 0.f;
#pragma unroll
    for (int i = 0; i < 32; ++i) y[i] = 0.f;
    for (int kk = 0; kk < 128 - PEER_RING; kk += PEER_RING) {
#pragma unroll
        for (int s_ = 0; s_ < PEER_RING; s_ += 2) { const int k = kk + s_;
            const float cka = rdl_f(k < 64 ? a0 : a1, k & 63), ckb = rdl_f(k < 64 ? a0 : a1, (k + 1) & 63);
            const unsigned cpair = __builtin_bit_cast(unsigned, __builtin_amdgcn_cvt_pkrtz(cka, ckb));
            PEER_ACC16(bx[PEER_S3 + s_].x, bx[PEER_S3 + s_ + 1].x, 0); PEER_ACC16(bx[PEER_S3 + s_].y, bx[PEER_S3 + s_ + 1].y, 8); PEER_ACC16(bx[PEER_S3 + s_].z, bx[PEER_S3 + s_ + 1].z, 16); PEER_ACC16(bx[PEER_S3 + s_].w, bx[PEER_S3 + s_ + 1].w, 24);
            csum = peer_dot2h(cpair, 0x3C003C00u, csum);
            const int kn = k + PEER_RING;
            if (kn < 128) { PEER_LD(PEER_S3 + s_, V, __builtin_amdgcn_readlane(kn < 64 ? e0 : e1, kn & 63)); PEER_LD(PEER_S3 + s_ + 1, V, __builtin_amdgcn_readlane(kn < 64 ? e0 : e1, (kn + 1) & 63)); }
            __builtin_amdgcn_sched_barrier(0); }
    }
    u32x2 xe[8]; { const bf16_t* xr1 = x16 + (size_t)t * D + 4 * lane;
#pragma unroll
      for (int c = 0; c < 8; ++c) xe[c] = *(const u32x2*)(xr1 + 256 * c); }
    __builtin_amdgcn_sched_barrier(0);
    { const int kk = 128 - PEER_RING;
#pragma unroll
        for (int s_ = 0; s_ < PEER_RING; s_ += 2) { const int k = kk + s_;
            const float cka = rdl_f(k < 64 ? a0 : a1, k & 63), ckb = rdl_f(k < 64 ? a0 : a1, (k + 1) & 63);
            const unsigned cpair = __builtin_bit_cast(unsigned, __builtin_amdgcn_cvt_pkrtz(cka, ckb));
            PEER_ACC16(bx[PEER_S3 + s_].x, bx[PEER_S3 + s_ + 1].x, 0); PEER_ACC16(bx[PEER_S3 + s_].y, bx[PEER_S3 + s_ + 1].y, 8); PEER_ACC16(bx[PEER_S3 + s_].z, bx[PEER_S3 + s_ + 1].z, 16); PEER_ACC16(bx[PEER_S3 + s_].w, bx[PEER_S3 + s_ + 1].w, 24);
            csum = peer_dot2h(cpair, 0x3C003C00u, csum);
            const int kn = k + PEER_RING;
            if (kn < 128) { PEER_LD(PEER_S3 + s_, V, __builtin_amdgcn_readlane(kn < 64 ? e0 : e1, kn & 63)); PEER_LD(PEER_S3 + s_ + 1, V, __builtin_amdgcn_readlane(kn < 64 ? e0 : e1, (kn + 1) & 63)); }
            __builtin_amdgcn_sched_barrier(0); }
    }
    bf16_t* xr = x16 + (size_t)t * D + 4 * lane; float ss = 0.f;
#pragma unroll
    for (int c = 0; c < 8; c += 2) { const f32x4 xl = x16_unpack(xe[c]), xh = x16_unpack(xe[c + 1]); const int b = 4 * c; const float off = 7.5f * csum;
        const float h0 = (y[b + 4] - y[b]) * 1048576.0f - off + xh.x, h1 = (y[b + 5] - y[b + 1]) * 1048576.0f - off + xh.y, h2 = (y[b + 6] - y[b + 2]) * 1048576.0f - off + xh.z, h3 = (y[b + 7] - y[b + 3]) * 1048576.0f - off + xh.w;
        y[b] = y[b] * 16777216.0f - off + xl.x; y[b + 1] = y[b + 1] * 16777216.0f - off + xl.y; y[b + 2] = y[b + 2] * 16777216.0f - off + xl.z; y[b + 3] = y[b + 3] * 16777216.0f - off + xl.w;
        y[b + 4] = h0; y[b + 5] = h1; y[b + 6] = h2; y[b + 7] = h3; }
#pragma unroll
    for (int i = 0; i < 32; ++i) ss += y[i] * y[i];
    const float r = 1.0f / sqrtf(wave_sum(ss) * (1.0f / D) + EPS);
    float gn[32];
#pragma unroll
    for (int c = 0; c < 8; ++c) { const f32x4 gv = *(const f32x4*)(gain_next + 256 * c + 4 * lane); gn[4 * c] = gv.x; gn[4 * c + 1] = gv.y; gn[4 * c + 2] = gv.z; gn[4 * c + 3] = gv.w; }
    if (out_final) {
#pragma unroll
        for (int c = 0; c < 8; ++c) { const int b = 4 * c; f32x4 o; o.x = y[b] * r * gn[b]; o.y = y[b + 1] * r * gn[b + 1]; o.z = y[b + 2] * r * gn[b + 2]; o.w = y[b + 3] * r * gn[b + 3];
            *(f32x4*)(out_final + (size_t)t * D + 256 * c + 4 * lane) = o; }
    } else {
#pragma unroll
        for (int c = 0; c < 8; ++c) { const int b = 4 * c; u32x2 o; o.x = pk2(y[b], y[b + 1]); o.y = pk2(y[b + 2], y[b + 3]); *(u32x2*)(xr + 256 * c) = o; }
        bf16_t* hp = h + (size_t)t * D + 4 * lane;
#pragma unroll
        for (int c = 0; c < 8; ++c) { const int b = 4 * c; u32x2 o; o.x = pk2(y[b] * r * gn[b], y[b + 1] * r * gn[b + 1]); o.y = pk2(y[b + 2] * r * gn[b + 2], y[b + 3] * r * gn[b + 3]);
            *(u32x2*)(hp + 256 * c) = o; }
    }
}

template <class Tp> __device__ __forceinline__ Tp* launder(Tp* p) { size_t z = 0; asm volatile("" : "+s"(z)); return (Tp*)((char*)p + z); }
__device__ __forceinline__ int opqv(int v) { asm volatile("" : "+v"(v)); return v; }
__device__ __forceinline__ int opq(int v) { asm volatile("" : "+s"(v)); return v; }
#define WSP(type, off) ((type*)(w_ + (off)))
#define XB_T0() (wave == 0 && __builtin_amdgcn_mbcnt_hi((unsigned)opq(-1), __builtin_amdgcn_mbcnt_lo((unsigned)opq(-1), 0u)) == 0u)
#define PHASE_BASE() unsigned char* w_ = launder(ws); const unsigned ones_ = (unsigned)opq(-1); const int lane = (int)__builtin_amdgcn_mbcnt_hi(ones_, __builtin_amdgcn_mbcnt_lo(ones_, 0u)), tid = wave * 64 + lane, gw = blockIdx.x * 8 + wave; (void)tid; (void)gw
#define INP(i) launder(a.in[i])

constexpr int LDS_TAB = 131072;
constexpr int TAB_MAX = 10;
__device__ __forceinline__ float sum8f(const float* p) { const f32x4 a = *(const f32x4*)p, b = *(const f32x4*)(p + 4); return ((a.x + a.y) + (a.z + a.w)) + ((b.x + b.y) + (b.z + b.w)); }
__device__ __forceinline__ float rs1024(float ssq) { return 1.0f / sqrtf(ssq * (1.0f / 1024.0f) + EPS); }
struct EpiResid2 {
    static constexpr bool PERM = true, AFTER_DRAIN = false; static constexpr int KSPLIT = 2;
    bf16_t* X; float* xp; const float* mp; const float* np; const LAS float* tab;
    __device__ __forceinline__ void scales(int ord, int row, int rloc, float& ratio, float& s2) const {
        if (ord < TAB_MAX) { const LAS float* t = tab + ord * 512 + rloc * 2; ratio = t[0]; s2 = t[1]; }
        else { const float s1 = rs1024(sum8f(mp + (size_t)row * 8)); s2 = rs1024(sum8f(np + (size_t)row * 8)); ratio = s1 / s2; } }
    __device__ __forceinline__ void mid(pg8::f32x4 (&acc)[2][2][4][2], const pg8::Unit& u, int wr, int wc, int fr, int fq, int ord) const {
        const int rl0 = opqv(wr * 64 + fr);
#pragma unroll
        for (int ai = 0; ai < 2; ++ai)
#pragma unroll
            for (int m = 0; m < 4; ++m) { const int rloc = rl0 + ai * 128 + m * 16; float ratio, s2; scales(ord, u.pm * 256 + rloc, rloc, ratio, s2);
#pragma unroll
                for (int bj = 0; bj < 2; ++bj)
#pragma unroll
                    for (int n = 0; n < 2; ++n) acc[ai][bj][m][n] = acc[ai][bj][m][n] * ratio; }
    }
    __device__ __forceinline__ void operator()(const pg8::f32x4 (&acc)[2][2][4][2], const pg8::Unit& u, int wr, int wc, int fr, int fq, int ord) const {
        const int rl0 = opqv(wr * 64 + fr), row0 = u.pm * 256 + rl0, col0 = u.pn * 256 + wc * 32 + 8 * fq;
#pragma unroll
        for (int ai = 0; ai < 2; ++ai) {
            u32x4 xv[4][2];
#pragma unroll
            for (int m = 0; m < 4; ++m) { const bf16_t* rowp = X + (size_t)(row0 + ai * 128 + m * 16) * D + col0;
#pragma unroll
                for (int bj = 0; bj < 2; ++bj) xv[m][bj] = *(const u32x4*)(rowp + bj * 128); }
            asm volatile("" ::: "memory");
#pragma unroll
            for (int m = 0; m < 4; ++m) { const int rloc = rl0 + ai * 128 + m * 16, row = u.pm * 256 + rloc; bf16_t* rowp = X + (size_t)row * D + col0; float ss = 0.f; float ratio_, s2; scales(ord, row, rloc, ratio_, s2); (void)ratio_;
#pragma unroll
                for (int bj = 0; bj < 2; ++bj) { const u32x4 p = xv[m][bj]; const f32x4 a0 = acc[ai][bj][m][0] * s2, a1 = acc[ai][bj][m][1] * s2;
                    u32x4 w; w.x = pk2(__uint_as_float(p.x << 16) + a0.x, __uint_as_float(p.x & 0xffff0000u) + a0.y); w.y = pk2(__uint_as_float(p.y << 16) + a0.z, __uint_as_float(p.y & 0xffff0000u) + a0.w);
                    w.z = pk2(__uint_as_float(p.z << 16) + a1.x, __uint_as_float(p.z & 0xffff0000u) + a1.y); w.w = pk2(__uint_as_float(p.w << 16) + a1.z, __uint_as_float(p.w & 0xffff0000u) + a1.w);
                    *(u32x4*)(rowp + bj * 128) = w;
#pragma unroll
                    for (int q = 0; q < 4; ++q) { const float lo = __uint_as_float(w[q] << 16), hi = __uint_as_float(w[q] & 0xffff0000u); ss += lo * lo + hi * hi; } }
                ss += __shfl_xor(ss, 16); ss += __shfl_xor(ss, 32);
                if (fq == 0) xp[(size_t)row * 32 + u.pn * 4 + wc] = ss; }
        }
    }
};
__device__ __forceinline__ void pf_tables(LAS float* tab, const float* __restrict__ mp, const float* __restrict__ np, const pg8::StaticOrder& S, int tid) {
    pg8::Unit u;
    for (int i = 0; i < 2 * TAB_MAX; i += 2) { if (!S.next(i / 2, u)) break;
        if (tid < 256) { const int row = u.pm * 256 + tid; const float s1 = rs1024(sum8f(mp + (size_t)row * 8)), s2 = rs1024(sum8f(np + (size_t)row * 8)); tab[(i / 2) * 512 + tid * 2] = s1 / s2; tab[(i / 2) * 512 + tid * 2 + 1] = s2; } }
}
struct EpiKV {
    static constexpr bool PERM = true, AFTER_DRAIN = false, ORD = true;
    bf16_t* O; const LAS float* tab; const float* lp;
    __device__ __forceinline__ void operator()(const pg8::f32x4 (&acc)[2][2][4][2], const pg8::Unit& u, int wr, int wc, int fr, int fq, int ord) const {
        const int rl0 = opqv(wr * 64 + fr); int colt = u.pn * 256; bf16_t* base = O;
        if (colt >= 1024) { base += (size_t)T * 1024; colt -= 1024; }
        const int col0 = colt + wc * 32 + 8 * fq;
#pragma unroll
        for (int ai = 0; ai < 2; ++ai)
#pragma unroll
            for (int m = 0; m < 4; ++m) { const int rloc = rl0 + ai * 128 + m * 16, row = u.pm * 256 + rloc; const float r = ord < 20 ? tab[ord * 256 + rloc] : lat_scale(lp + (size_t)row * 16 + 8, 4, 256.0f); bf16_t* rowp = base + (size_t)row * 1024 + col0;
#pragma unroll
                for (int bj = 0; bj < 2; ++bj) { const f32x4 v0 = acc[ai][bj][m][0] * r, v1 = acc[ai][bj][m][1] * r;
                    u32x4 w; w.x = pk2(v0.x, v0.y); w.y = pk2(v0.z, v0.w); w.z = pk2(v1.x, v1.y); w.w = pk2(v1.z, v1.w);
                    *(u32x4*)(rowp + bj * 128) = w; } }
    }
};
__device__ __forceinline__ void lat_tables(LAS float* tab, const float* __restrict__ lp, int off, int n, float dim, const pg8::StaticOrder& S, int tid) {
    pg8::Unit u;
    for (int i = 0; i < 20; ++i) { if (!S.next(i, u)) break;
        if (tid < 256) tab[i * 256 + tid] = lat_scale(lp + (size_t)(u.pm * 256 + tid) * 16 + off, n, dim); }
}
struct EpiRowScale {
    static constexpr bool PERM = true, AFTER_DRAIN = false, ORD = true;
    bf16_t* O; const float* xp; const LAS float* tab; int ldc, pad;
    static __device__ __forceinline__ float rowscale(const float* p) { float t = 0.f;
#pragma unroll
        for (int i = 0; i < 4; ++i) t += sum8f(p + 8 * i);
        return 1.0f / sqrtf(t * (1.0f / D) + EPS); }
    __device__ __forceinline__ void operator()(const pg8::f32x4 (&acc)[2][2][4][2], const pg8::Unit& u, int wr, int wc, int fr, int fq, int ord) const {
        const int rl0 = opqv(wr * 64 + fr), col0 = u.pn * 256 + wc * 32 + 8 * fq;
#pragma unroll
        for (int ai = 0; ai < 2; ++ai)
#pragma unroll
            for (int m = 0; m < 4; ++m) { const int rloc = rl0 + ai * 128 + m * 16, row = u.pm * 256 + rloc; const float r = ord < 2 * TAB_MAX ? tab[ord * 256 + rloc] : rowscale(xp + (size_t)row * 32); bf16_t* rowp = O + (size_t)row * ldc + col0;
#pragma unroll
                for (int bj = 0; bj < 2; ++bj) { const f32x4 v0 = acc[ai][bj][m][0] * r, v1 = acc[ai][bj][m][1] * r;
                    u32x4 w; w.x = pk2(v0.x, v0.y); w.y = pk2(v0.z, v0.w); w.z = pk2(v1.x, v1.y); w.w = pk2(v1.z, v1.w);
                    *(u32x4*)(rowp + bj * 128) = w; } }
    }
};
__device__ __forceinline__ void ph_tables(LAS float* tab, const float* __restrict__ xp, const pg8::StaticOrder& S, int tid) {
    pg8::Unit u;
    for (int i = 0; i < 2 * TAB_MAX; ++i) { if (!S.next(i, u)) break;
        if (tid < 256) tab[i * 256 + tid] = EpiRowScale::rowscale(xp + (size_t)(u.pm * 256 + tid) * 32); }
}
__global__ void __launch_bounds__(512, 2) mk_fwd(MkArgs a) {
    extern __shared__ __attribute__((aligned(16))) unsigned char lds_raw[];
    LAS unsigned char* lds = (LAS unsigned char*)lds_raw;
    const int tid0 = threadIdx.x, wave = __builtin_amdgcn_readfirstlane(tid0 >> 6);
    const int G = gridDim.x, NGW = G * 8;
    unsigned char* ws = a.ws;
    if (tid0 < 4) ((LAS unsigned*)(lds + LDS_BAR_OFF))[tid0] = 0u;
    __syncthreads();
    XcdBarrier bar = xcd_barrier_post((unsigned*)(ws + WS_CTL), (volatile LAS unsigned*)(lds + LDS_BAR_OFF));

    {
        PHASE_BASE(); LAS float* scr = (LAS float*)(lds + wave * 16384);
        unsigned* KT = WSP(unsigned, WS_KT); float* rope = WSP(float, WS_ROPE); const float* sk = INP(13);
        conv_w_all(INP(2), WSP(bf16_t, WS_WIN), D, DIN, DINP, 0, scr, gw, NGW, lane);
        conv_w_all(INP(4), WSP(bf16_t, WS_WUQ), 512, 1536, 1536, 1, scr, gw, NGW, lane, INP(3));
        conv_w_all(INP(6), WSP(bf16_t, WS_WUKV), 256, 2048, 2048, 2, scr, gw, NGW, lane, INP(5));
        conv_w_all(INP(10), WSP(bf16_t, WS_WOUT), D, D, D, 3, scr, gw, NGW, lane, INP(8), INP(9));
        conv_w_all(INP(12), WSP(bf16_t, WS_WPQ), D, D, D, 3, scr, gw, NGW, lane, INP(11));
        const size_t gt = (size_t)blockIdx.x * 512 + tid, NGT = (size_t)G * 512;
        { const float* pu = INP(14); const float* pv = INP(15); unsigned char* Uq = WSP(unsigned char, WS_U); unsigned char* Vq = WSP(unsigned char, WS_V); bf16_t* Us = WSP(bf16_t, WS_US); bf16_t* Vs = WSP(bf16_t, WS_VS);
          for (int r = gw; r < NL * 16384; r += 2 * NGW) {
              const int r2 = r + NGW; f32x4 a0[8], b0[8], a1[8], b1[8];
              quant_load(a0, pu + (size_t)r * D, lane); quant_load(b0, pv + (size_t)r * D, lane); const bool two = r2 < NL * 16384; if (two) { quant_load(a1, pu + (size_t)r2 * D, lane); quant_load(b1, pv + (size_t)r2 * D, lane); }
              quant_finish(a0, Uq + (size_t)r * PROW, Us + (size_t)r, lane, 0x88888888u); quant_finish(b0, Vq + (size_t)r * PROW, Vs + (size_t)r, lane, 0u);
              if (two) { quant_finish(a1, Uq + (size_t)r2 * PROW, Us + (size_t)r2, lane, 0x88888888u); quant_finish(b1, Vq + (size_t)r2 * PROW, Vs + (size_t)r2, lane, 0u); } } }
        conv_bf16_all(sk, (bf16_t*)KT, (size_t)NL * 2 * 128 * 128 / 8, gt, NGT);
        for (size_t i = gt; i < (size_t)SEQ * 32; i += NGT) { const int s = (int)i >> 5, j = (int)i & 31;
            double rev = (double)s * ROPE_REV[j]; rev -= __builtin_rint(rev); const float r = (float)rev;
            rope[s * 64 + j] = __builtin_amdgcn_cosf(r); rope[s * 64 + 32 + j] = __builtin_amdgcn_sinf(r); }
        { const float* x = INP(0); const float* attn_norm = INP(1); bf16_t* h = WSP(bf16_t, WS_H); bf16_t* x16 = WSP(bf16_t, WS_X32);
          for (int t = gw; t < T; t += NGW) norm_x_row(x + (size_t)t * D, attn_norm, h + (size_t)t * D, x16 + (size_t)t * D, lane); }
    }
    xcd_barrier(bar, XB_T0());

    const float qscale = 0.07216878364870322f;
    for (int l = 0; l < NL; ++l) {
        { PHASE_BASE();
          pg8::Gemm g{WSP(bf16_t, WS_H), WSP(bf16_t, WS_WIN) + (size_t)l * DINP * D, T, DINP, opq(D), 0};
          EpiIn E{WSP(bf16_t, WS_CQ), WSP(bf16_t, WS_CKV), WSP(bf16_t, WS_NQ), WSP(bf16_t, WS_NK), WSP(bf16_t, WS_NV), WSP(bf16_t, WS_KPE), WSP(float, WS_ROPE), WSP(float, WS_LP)};
          pg8::StaticOrder S; S.init(T, DINP, G, (int)blockIdx.x);
          pg8::gemm_phase<EpiIn, pg8::StaticOrder>(lds, g, S, E, nullptr, wave); }
        xcd_barrier(bar, XB_T0());
        { PHASE_BASE(); pg8::Gemm g{WSP(bf16_t, WS_CQ), WSP(bf16_t, WS_WUQ) + (size_t)l * 1536 * 512, T, 1536, opq(512), 0}; EpiQ E{WSP(bf16_t, WS_Q), WSP(float, WS_ROPE), (const LAS float*)(lds + LDS_TAB), WSP(float, WS_LP), qscale, 0};
          pg8::StaticOrder S; S.init(T, 1536, G, (int)blockIdx.x);
          lat_tables((LAS float*)(lds + LDS_TAB), WSP(float, WS_LP), 0, 8, 512.0f, S, tid); __syncthreads();
          pg8::gemm_phase<EpiQ, pg8::StaticOrder>(lds, g, S, E, nullptr, wave); }
        { PHASE_BASE(); pg8::Gemm g{WSP(bf16_t, WS_CKV), WSP(bf16_t, WS_WUKV) + (size_t)l * 2048 * 256, T, 2048, opq(256), 0}; EpiKV E{WSP(bf16_t, WS_KN), (const LAS float*)(lds + LDS_TAB), WSP(float, WS_LP)};
          pg8::StaticOrder S; S.init(T, 2048, G, (int)blockIdx.x);
          __syncthreads(); lat_tables((LAS float*)(lds + LDS_TAB), WSP(float, WS_LP), 8, 4, 256.0f, S, tid); __syncthreads();
          pg8::gemm_phase<EpiKV, pg8::StaticOrder>(lds, g, S, E, nullptr, wave); }
        {
            PHASE_BASE(); LAS float* rp = (LAS float*)(lds + natm::OFF_RP); const float* rpb = INP(7);
            bf16_t* nq = WSP(bf16_t, WS_NQ); bf16_t* nk = WSP(bf16_t, WS_NK); bf16_t* nv = WSP(bf16_t, WS_NV); bf16_t* mix = WSP(bf16_t, WS_MIX); float* nss = WSP(float, WS_NP);
            __syncthreads();
            for (int i = tid; i < 16 * 15 * 31; i += 512) rp[i] = rpb[(size_t)l * 7440 + i];
            const int vcu = (G % 8 == 0) ? ((int)blockIdx.x % 8) * (G / 8) + (int)blockIdx.x / 8 : (int)blockIdx.x;
            for (int u = vcu; u < 512; u += G) { __syncthreads(); natm::nat_unit(u, opqv(tid), nq, nk, nv, mix + 1024, nss, (LAS char*)lds); }
        }
        xcd_barrier(bar, XB_T0());
        { PHASE_BASE(); const int vcu = (G % 8 == 0) ? ((int)blockIdx.x % 8) * (G / 8) + (int)blockIdx.x / 8 : (int)blockIdx.x;
          const bf16_t* Q = WSP(bf16_t, WS_Q); const bf16_t* Kn = WSP(bf16_t, WS_KN); const bf16_t* Vv = WSP(bf16_t, WS_VV); const bf16_t* kpe = WSP(bf16_t, WS_KPE); bf16_t* mix = WSP(bf16_t, WS_MIX); float* mss = WSP(float, WS_MP);
          for (int u = vcu; u < 512; u += G) { const int qblk = u & 7, hd = (u >> 3) & 7, b = u >> 6; const size_t t0 = (size_t)b * 2048;
            __syncthreads();
            mla::attn_unit(opqv(tid), Q + (t0 + qblk * 256) * 1536 + hd * 192, Kn + t0 * 1024 + hd * 128, Vv + t0 * 1024 + hd * 128, kpe + t0 * 64, mix + (t0 + qblk * 256) * 2048 + hd * 128, mss + (t0 + qblk * 256) * 8 + hd, (LAS char*)lds); } }
        xcd_barrier(bar, XB_T0());
        { PHASE_BASE(); pg8::Gemm g{WSP(bf16_t, WS_MIX), WSP(bf16_t, WS_WOUT) + (size_t)l * D * D, T, D, opq(D), 0}; EpiResid2 E{WSP(bf16_t, WS_X32), WSP(float, WS_XP), WSP(float, WS_MP), WSP(float, WS_NP), (const LAS float*)(lds + LDS_TAB)};
          pg8::StaticOrder S; S.init(T, D, G, (int)blockIdx.x);
          pf_tables((LAS float*)(lds + LDS_TAB), WSP(float, WS_MP), WSP(float, WS_NP), S, tid); __syncthreads();
          pg8::gemm_phase<EpiResid2, pg8::StaticOrder>(lds, g, S, E, nullptr, wave); }
        xcd_barrier(bar, XB_T0());
        { PHASE_BASE(); pg8::Gemm g{WSP(bf16_t, WS_X32), WSP(bf16_t, WS_WPQ) + (size_t)l * D * D, T, D, opq(D), 0}; EpiRowScale E{WSP(bf16_t, WS_PQ), WSP(float, WS_XP), (const LAS float*)(lds + LDS_TAB), D, 0};
          pg8::StaticOrder S; S.init(T, D, G, (int)blockIdx.x);
          ph_tables((LAS float*)(lds + LDS_TAB), WSP(float, WS_XP), S, tid); __syncthreads();
          pg8::gemm_phase<EpiRowScale, pg8::StaticOrder>(lds, g, S, E, nullptr, wave); }
        xcd_barrier(bar, XB_T0());
        {
            PHASE_BASE(); LAS unsigned char* keys = lds; const bf16_t* KB = WSP(bf16_t, WS_KT) + (size_t)l * 2 * 128 * 128; const float* final_norm = INP(16); const float* attn_norm = INP(1); const float* ffn_norm = INP(11);
            bf16_t* pq = WSP(bf16_t, WS_PQ); const unsigned char* Uq = WSP(unsigned char, WS_U); const unsigned char* Vq = WSP(unsigned char, WS_V); bf16_t* x16 = WSP(bf16_t, WS_X32); bf16_t* h = WSP(bf16_t, WS_H);
            LAS float* Lv = (LAS float*)(lds + 69632 + wave * 4096); LAS int* Ln = (LAS int*)(Lv + 256); LAS int* idxs = Ln + 256; LAS float* gs = (LAS float*)(idxs + 128);
            for (int i = tid; i < 256 * 16; i += 512) { const int row = i >> 4, ch = i & 15; *(LAS u32x4*)(keys + row * 272 + ch * 16) = *(const u32x4*)(KB + row * 128 + ch * 8); }
            __syncthreads();
            const bool last = (l == NL - 1);
            LAS unsigned* save = (LAS unsigned*)(lds + 102400 + wave * 6144);
            for (int tb = gw; tb < T; tb += 8 * NGW) {
                { int nt = 0;
                  for (int t = tb; t < T && nt < 8; t += NGW, ++nt) { const int ln = opqv(lane); rt_bf16x8 aq[4]; peer_load_q(t, ln, pq, aq);
                    u32x2 xin[8];
                    { const bf16_t* xr0 = x16 + (size_t)t * D + 4 * ln;
#pragma unroll
                      for (int c = 0; c < 8; ++c) xin[c] = *(const u32x2*)(xr0 + 256 * c); }
                    __builtin_amdgcn_sched_barrier(0);
                    peer_route(ln, keys, Lv, Ln, idxs, gs, aq);
                    peer_stage1(ln, idxs, gs, Uq + (size_t)l * 16384 * PROW, WSP(bf16_t, WS_US) + (size_t)l * 16384, WSP(bf16_t, WS_VS) + (size_t)l * 16384, xin, ffn_norm + l * D, save + nt * 192); } }
                { int nt = 0;
                  for (int t = tb; t < T && nt < 8; t += NGW, ++nt) { const int ln = opqv(lane);
                    peer_stage3(t, ln, save + nt * 192, Vq + (size_t)l * 16384 * PROW, x16, h, last ? final_norm : attn_norm + (l + 1) * D, last ? a.out : nullptr); } }
            }
        }
        if (l + 1 < NL) xcd_barrier(bar, XB_T0());
    }
}

extern "C" void kernel_launch(void* const* d_in, const int* in_sizes, int n_in, void* d_out, int out_size, void* d_ws, size_t ws_size, hipStream_t stream) {
    static int grid = 0;
    if (grid == 0) {
        if (n_in != 17 || ws_size < WS_END) { fprintf(stderr, "kernel_launch: unexpected n_in %d / ws_size %zu (need %zu)\n", n_in, ws_size, (size_t)WS_END); grid = -1; return; }
        int dev = 0, cus = 0, per_cu = 0;
        if (hipGetDevice(&dev) != hipSuccess || hipDeviceGetAttribute(&cus, hipDeviceAttributeMultiprocessorCount, dev) != hipSuccess) { grid = -1; return; }
        if (hipFuncSetAttribute((const void*)mk_fwd, hipFuncAttributeMaxDynamicSharedMemorySize, LDS_BYTES) != hipSuccess) { fprintf(stderr, "kernel_launch: hipFuncSetAttribute failed\n"); grid = -1; return; }
        if (hipOccupancyMaxActiveBlocksPerMultiprocessor(&per_cu, (const void*)mk_fwd, 512, LDS_BYTES) != hipSuccess || per_cu < 1) { fprintf(stderr, "kernel_launch: occupancy query says %d\n", per_cu); }
        (void)hipGetLastError();
        grid = cus;
    }
    if (grid < 0) return;
    (void)hipMemsetAsync((char*)d_ws + WS_CTL, 0, XCD_BAR_WORDS * sizeof(unsigned), stream);
    MkArgs a{};
    for (int i = 0; i < 17; ++i) a.in[i] = (const float*)d_in[i];
    a.out = (float*)d_out; a.ws = (unsigned char*)d_ws;
    hipLaunchKernelGGL(mk_fwd, dim3(grid), dim3(512), LDS_BYTES, stream, a);
}
```
